# Optimizing an MI355X kernel written in HIP

```python
import jax, jax.numpy as jnp
from jax import lax
import numpy as np

D_MODEL = 1024
BATCH = 16
SEQ = 2048
DEPTH = 4
DEC_BATCH = 2
DEC_SEQ = 16384
PAST_LEN = 128

HEAD_DIM = 64
N_GROUPS = 4
MIX_W = D_MODEL
GROUP_W = MIX_W // N_GROUPS
GROUP_HEADS = GROUP_W // HEAD_DIM
A_HEADS = GROUP_HEADS
A_CONFIGS = ((128, 1), (512, 4), (2048, 16))
A_BLOCK = 64
B_HEADS = GROUP_HEADS
B_KV_HEADS = 2
B_HALF_WINDOW = 128
B_BLOCK = 128
C_HEADS = GROUP_HEADS
C_Q_RANK = 256
C_KV_RANK = 128
C_NOPE = 64
C_ROPE = 32
C_V = HEAD_DIM
C_QBLOCK = 128
ROPE_THETA = 10000.0
D_HEADS = GROUP_HEADS
GRID_W = 64
NA_KH = 8
NA_KW = 16
D_FF = 4 * D_MODEL
EPS = 1e-5
NEG_INF = -1e30
N_ALIBI_HEADS = A_HEADS + B_HEADS
IN_SECTIONS = (GROUP_W, GROUP_W, GROUP_W,
               GROUP_W, B_KV_HEADS * HEAD_DIM, B_KV_HEADS * HEAD_DIM,
               C_Q_RANK, C_KV_RANK, C_ROPE,
               GROUP_W, GROUP_W, GROUP_W)
IN_W = sum(IN_SECTIONS)

kernel_name = 'hybrid_parallel_group_encoder'


def rmsnorm(x, g):
    xf = x.astype(jnp.float32)
    y = xf * lax.rsqrt(jnp.mean(xf * xf, axis=-1, keepdims=True) + EPS)
    return (y * g.astype(jnp.float32)).astype(x.dtype)


def split_points():
    return np.cumsum(np.array(IN_SECTIONS))[:-1].tolist()


def alibi_slopes():
    return jnp.exp2(-8.0 * jnp.arange(1, N_ALIBI_HEADS + 1, dtype=jnp.float32) / N_ALIBI_HEADS)


def rope_tables(S):
    inv_freq = 1.0 / (ROPE_THETA ** (jnp.arange(0, C_ROPE, 2, dtype=jnp.float32) / C_ROPE))
    ang = jnp.arange(S, dtype=jnp.float32)[:, None] * inv_freq[None, :]
    return jnp.cos(ang), jnp.sin(ang)


def rotate(x, cos, sin):
    x1, x2 = jnp.split(x.astype(jnp.float32), 2, axis=-1)
    return jnp.concatenate([x1 * cos - x2 * sin, x1 * sin + x2 * cos], axis=-1).astype(x.dtype)


def banded_attention(q, k, v, half_window, block, slopes, dist_scale, sink=None):
    N, L, H, dh = q.shape
    Hkv = k.shape[2]
    G = H // Hkv
    nb = -(-L // block)
    Lp = nb * block
    pad = Lp - L
    qb = jnp.pad(q, ((0, 0), (0, pad), (0, 0), (0, 0))).reshape(N, nb, block, Hkv, G, dh)

    def windows(a):
        ap = jnp.pad(a, ((0, 0), (block, pad + block), (0, 0), (0, 0))).reshape(N, nb + 2, block, Hkv, dh)
        return jnp.concatenate([ap[:, :-2], ap[:, 1:-1], ap[:, 2:]], axis=2)

    kw, vw = windows(k), windows(v)
    qi = jnp.arange(block)
    kj = jnp.arange(3 * block)
    rel = kj[None, :] - block - qi[:, None]
    kpos = (jnp.arange(nb)[:, None] - 1) * block + kj[None, :]
    mask = (jnp.abs(rel) <= half_window)[None] & ((kpos >= 0) & (kpos < L))[:, None, :]
    s = jnp.einsum('nbqkgd,nbskd->nbkgqs', qb, kw, preferred_element_type=jnp.float32) * (dh ** -0.5)
    dist = jnp.abs(rel).astype(jnp.float32) * dist_scale
    s = s - slopes.astype(jnp.float32).reshape(Hkv, G)[:, :, None, None] * dist[None, None]
    s = jnp.where(mask[None, :, None, None], s, NEG_INF)
    m = jnp.max(s, axis=-1, keepdims=True)
    if sink is not None:
        sink_b = sink.astype(jnp.float32).reshape(Hkv, G)[:, :, None, None]
        m = jnp.maximum(m, sink_b)
    p = jnp.exp(s - m)
    den = jnp.sum(p, axis=-1, keepdims=True)
    if sink is not None:
        den = den + jnp.exp(sink_b - m)
    p = p / den
    o = jnp.einsum('nbkgqs,nbskd->nbqkgd', p.astype(v.dtype), vw, preferred_element_type=jnp.float32)
    o = o.reshape(N, Lp, H, dh)[:, :L].astype(q.dtype)
    lse = (m + jnp.log(den))[..., 0].transpose(0, 1, 4, 2, 3).reshape(N, Lp, H)[:, :L]
    return o, lse


def dilated_attention(q, k, v, slopes):
    B, S, H, dh = q.shape
    outs, lses = [], []
    for window, dil in A_CONFIGS:
        L = S // dil

        def to_strided(a):
            return a.reshape(B, L, dil, H, dh).transpose(0, 2, 1, 3, 4).reshape(B * dil, L, H, dh)

        o, lse = banded_attention(to_strided(q), to_strided(k), to_strided(v),
                                  window // (2 * dil), A_BLOCK, slopes, float(dil))
        outs.append(o.reshape(B, dil, L, H, dh).transpose(0, 2, 1, 3, 4).reshape(B, S, H, dh))
        lses.append(lse.reshape(B, dil, L, H).transpose(0, 2, 1, 3).reshape(B, S, H))
    w = jax.nn.softmax(jnp.stack(lses, axis=0), axis=0)
    o = jnp.sum(w[..., None] * jnp.stack(outs, axis=0).astype(jnp.float32), axis=0)
    return o.astype(q.dtype)


def latent_attention(c_q, c_kv, k_rope, q_norm, w_q_up, kv_norm, w_kv_up, cos, sin):
    B, S, _ = c_q.shape
    q = jnp.einsum('bsr,re->bse', rmsnorm(c_q, q_norm), w_q_up).reshape(B, S, C_HEADS, C_NOPE + C_ROPE)
    q_nope = q[..., :C_NOPE]
    q_pe = rotate(q[..., C_NOPE:], cos[:, None], sin[:, None])
    kv = jnp.einsum('bsr,re->bse', rmsnorm(c_kv, kv_norm), w_kv_up).reshape(B, S, C_HEADS, C_NOPE + C_V)
    k_nope, v = kv[..., :C_NOPE], kv[..., C_NOPE:]
    k_pe = rotate(k_rope, cos, sin)
    scale = (C_NOPE + C_ROPE) ** -0.5
    nq = S // C_QBLOCK
    qn_blocks = q_nope.reshape(B, nq, C_QBLOCK, C_HEADS, C_NOPE).transpose(1, 0, 2, 3, 4)
    qp_blocks = q_pe.reshape(B, nq, C_QBLOCK, C_HEADS, C_ROPE).transpose(1, 0, 2, 3, 4)

    def attend(blk):
        qn_b, qp_b = blk
        s = (jnp.einsum('bqhd,bshd->bhqs', qn_b, k_nope, preferred_element_type=jnp.float32)
             + jnp.einsum('bqhr,bsr->bhqs', qp_b, k_pe, preferred_element_type=jnp.float32)) * scale
        p = jax.nn.softmax(s, axis=-1)
        return jnp.einsum('bhqs,bshd->bqhd', p.astype(v.dtype), v,
                          preferred_element_type=jnp.float32).astype(v.dtype)

    o = lax.map(attend, (qn_blocks, qp_blocks))
    return o.transpose(1, 0, 2, 3, 4).reshape(B, S, C_HEADS, C_V)


def neighborhood_attention(q, k, v, rpb):
    B, S, H, dh = q.shape
    rows = S // GRID_W
    kh = min(NA_KH, rows)
    r = jnp.arange(rows)
    row_start = jnp.clip(r - kh // 2, 0, rows - kh)
    row_idx = row_start[:, None] + jnp.arange(kh)[None, :]
    c = jnp.arange(GRID_W)
    col_start = jnp.clip(c - NA_KW // 2, 0, GRID_W - NA_KW)
    col_mask = (c[None, :] >= col_start[:, None]) & (c[None, :] < col_start[:, None] + NA_KW)
    qg = q.reshape(B, rows, GRID_W, H, dh)
    kg = k.reshape(B, rows, GRID_W, H, dh)[:, row_idx]
    vg = v.reshape(B, rows, GRID_W, H, dh)[:, row_idx]
    dr = row_idx - r[:, None] + (NA_KH - 1)
    dc = jnp.clip(c[None, :] - c[:, None], -(NA_KW - 1), NA_KW - 1) + (NA_KW - 1)
    bias = rpb.astype(jnp.float32)[:, dr][:, :, :, dc]
    bias = bias.transpose(0, 1, 3, 2, 4)
    bias = jnp.where(col_mask[None, None, :, None, :], bias, NEG_INF)
    s = jnp.einsum('brchd,briwhd->bhrciw', qg, kg, preferred_element_type=jnp.float32) * (dh ** -0.5)
    s = s + bias[None]
    p = jax.nn.softmax(s.reshape(B, H, rows, GRID_W, kh * GRID_W), axis=-1)
    p = p.reshape(B, H, rows, GRID_W, kh, GRID_W)
    o = jnp.einsum('bhrciw,briwhd->brchd', p.astype(v.dtype), vg, preferred_element_type=jnp.float32)
    return o.reshape(B, S, H, dh).astype(q.dtype)


def encoder_layer(x, lp, cos, sin, slopes_a, slopes_b):
    (norm_attn, w_in, mla_q_norm, w_q_up, mla_kv_norm, w_kv_up, sink_logits, na_rpb,
     group_norm, w_out, norm_mlp, w_mlp_up, w_mlp_down) = lp
    B, S, _ = x.shape
    h = rmsnorm(x, norm_attn)
    proj = jnp.einsum('bsd,de->bse', h, w_in)
    a_q, a_k, a_v, b_q, b_k, b_v, c_q, c_kv, c_kr, d_q, d_k, d_v = jnp.split(proj, split_points(), axis=-1)

    def heads(t):
        return t.reshape(B, S, -1, HEAD_DIM)

    o_a = dilated_attention(heads(a_q), heads(a_k), heads(a_v), slopes_a)
    o_b, _ = banded_attention(heads(b_q), heads(b_k), heads(b_v), B_HALF_WINDOW, B_BLOCK,
                              slopes_b, 1.0, sink_logits)
    o_c = latent_attention(c_q, c_kv, c_kr, mla_q_norm, w_q_up, mla_kv_norm, w_kv_up, cos, sin)
    o_d = neighborhood_attention(heads(d_q), heads(d_k), heads(d_v), na_rpb)
    o = jnp.concatenate([o_a.reshape(B, S, GROUP_W), o_b.reshape(B, S, GROUP_W),
                         o_c.reshape(B, S, GROUP_W), o_d.reshape(B, S, GROUP_W)], axis=-1)
    o = rmsnorm(o.reshape(B, S, N_GROUPS, GROUP_W), group_norm).reshape(B, S, MIX_W)
    x = x + jnp.einsum('bse,ed->bsd', o, w_out)
    h = rmsnorm(x, norm_mlp)
    u = jnp.square(jax.nn.relu(jnp.einsum('bsd,df->bsf', h, w_mlp_up)))
    return x + jnp.einsum('bsf,fd->bsd', u, w_mlp_down)


def encoder_trunk(x, params, norm_final):
    S = x.shape[1]
    cos, sin = rope_tables(S)
    slopes = alibi_slopes()
    slopes_a, slopes_b = slopes[1::2], slopes[0::2]
    for layer in range(DEPTH):
        x = encoder_layer(x, tuple(p[layer] for p in params), cos, sin, slopes_a, slopes_b)
    return rmsnorm(x, norm_final)


def setup_inputs(seed: int = 0) -> dict:
    key = jax.random.key(seed)
    ks = jax.random.split(key, 16)

    def normal(k, shape, scale):
        return scale * jax.random.normal(k, shape, jnp.float32)

    def gain(k, shape):
        return 1.0 + 0.05 * jax.random.normal(k, shape, jnp.float32)

    return {
        'x_prompt': normal(ks[0], (BATCH, SEQ, D_MODEL), 1.0),
        'x_sample': normal(ks[1], (DEC_BATCH, DEC_SEQ, D_MODEL), 1.0),
        'norm_attn': gain(ks[2], (DEPTH, D_MODEL)),
        'w_in': normal(ks[3], (DEPTH, D_MODEL, IN_W), D_MODEL ** -0.5),
        'mla_q_norm': gain(ks[4], (DEPTH, C_Q_RANK)),
        'w_q_up': normal(ks[5], (DEPTH, C_Q_RANK, C_HEADS * (C_NOPE + C_ROPE)), C_Q_RANK ** -0.5),
        'mla_kv_norm': gain(ks[6], (DEPTH, C_KV_RANK)),
        'w_kv_up': normal(ks[7], (DEPTH, C_KV_RANK, C_HEADS * (C_NOPE + C_V)), C_KV_RANK ** -0.5),
        'sink_logits': normal(ks[8], (DEPTH, B_HEADS), 0.5),
        'na_rpb': normal(ks[9], (DEPTH, D_HEADS, 2 * NA_KH - 1, 2 * NA_KW - 1), 0.1),
        'group_norm': gain(ks[10], (DEPTH, N_GROUPS, GROUP_W)),
        'w_out': normal(ks[11], (DEPTH, MIX_W, D_MODEL), MIX_W ** -0.5),
        'norm_mlp': gain(ks[12], (DEPTH, D_MODEL)),
        'w_mlp_up': normal(ks[13], (DEPTH, D_MODEL, D_FF), D_MODEL ** -0.5),
        'w_mlp_down': normal(ks[14], (DEPTH, D_FF, D_MODEL), D_FF ** -0.5),
        'norm_final': gain(ks[15], (D_MODEL,)),
    }


def reference(x_prompt, x_sample, norm_attn, w_in, mla_q_norm, w_q_up, mla_kv_norm, w_kv_up,
              sink_logits, na_rpb, group_norm, w_out, norm_mlp, w_mlp_up, w_mlp_down, norm_final):
    params = (norm_attn, w_in, mla_q_norm, w_q_up, mla_kv_norm, w_kv_up, sink_logits, na_rpb,
              group_norm, w_out, norm_mlp, w_mlp_up, w_mlp_down)
    y_prompt = encoder_trunk(x_prompt, params, norm_final)
    y_sample = encoder_trunk(x_sample, params, norm_final)
    return (y_prompt, y_sample)
```

```cpp
#include <hip/hip_runtime.h>
#include <hip/hip_cooperative_groups.h>
#include <cstdint>
#include <cstdio>
namespace cg = cooperative_groups;

#define DI __device__ __forceinline__
#define LAS __attribute__((address_space(3)))

typedef unsigned short bf16_t;
typedef short bf16x8 __attribute__((ext_vector_type(8)));
typedef short s16x4 __attribute__((ext_vector_type(4)));
typedef float f32x4 __attribute__((ext_vector_type(4)));
typedef float f32x16 __attribute__((ext_vector_type(16)));
typedef unsigned u32x4 __attribute__((ext_vector_type(4)));
typedef unsigned u32x2 __attribute__((ext_vector_type(2)));

#ifndef TILE_GM
#define TILE_GM 4
#endif
#ifndef TRIVIAL_MAP
#define TRIVIAL_MAP 0
#endif
#ifndef PH_MASK
#define PH_MASK 0x1FFF
#endif
constexpr int DM = 1024, TC = 32768, DEPTH = 4, PLD = 2560, INW = 2464, DFF = 4096;
constexpr int OFF_AQ = 0, OFF_AK = 256, OFF_AV = 512, OFF_BQ = 768, OFF_BK = 1024, OFF_BV = 1152,
              OFF_CQ = 1280, OFF_CKV = 1536, OFF_CKR = 1664, OFF_DQ = 1696, OFF_DK = 1952, OFF_DV = 2208;
constexpr float EPS = 1e-5f;
constexpr float LOG2E = 1.4426950408889634f;

constexpr size_t WS_BAR = 0;
constexpr size_t WS_ROPE = 16384;
constexpr size_t WS_WIN = WS_ROPE + 2u * 16384u * 16u * 4u;
constexpr size_t SZ_WIN = (size_t)DEPTH * PLD * DM * 2;
constexpr size_t WS_WQUP = WS_WIN + SZ_WIN;
constexpr size_t SZ_WQUP = (size_t)DEPTH * 384 * 256 * 2;
constexpr size_t WS_WKVUP = WS_WQUP + SZ_WQUP;
constexpr size_t SZ_WKVUP = (size_t)DEPTH * 512 * 128 * 2;
constexpr size_t WS_WOUT = WS_WKVUP + SZ_WKVUP;
constexpr size_t SZ_WOUT = (size_t)DEPTH * DM * DM * 2;
constexpr size_t WS_WUP = WS_WOUT + SZ_WOUT;
constexpr size_t SZ_WUP = (size_t)DEPTH * DFF * DM * 2;
constexpr size_t WS_WDOWN = WS_WUP + SZ_WUP;
constexpr size_t SZ_WDOWN = (size_t)DEPTH * DM * DFF * 2;
constexpr size_t WS_H = WS_WDOWN + SZ_WDOWN;
constexpr size_t SZ_H = (size_t)TC * DM * 2;
constexpr size_t WS_U = WS_H + SZ_H;
constexpr size_t SZ_U = (size_t)TC * DFF * 2;
constexpr size_t WS_PROJ = WS_U;
constexpr size_t WS_QC = WS_PROJ + (size_t)TC * PLD * 2;
constexpr size_t WS_KVC = WS_QC + (size_t)TC * 384 * 2;
constexpr size_t WS_CQN = WS_U + SZ_U;
constexpr size_t WS_CKVN = WS_CQN + (size_t)TC * 256 * 2;
constexpr size_t WS_KPE = WS_CKVN + (size_t)TC * 128 * 2;
constexpr size_t WS_END = WS_KPE + (size_t)TC * 32 * 2;
static_assert(WS_KVC + (size_t)TC * 512 * 2 <= WS_END, "alias region");

struct Params {
    const float* x_in[2];
    float* x_out[2];
    const float *norm_attn, *w_in, *mla_q_norm, *w_q_up, *mla_kv_norm, *w_kv_up, *sink_logits, *na_rpb, *group_norm, *w_out,
        *norm_mlp, *w_mlp_up, *w_mlp_down, *norm_final;
    unsigned char* ws;
};

DI unsigned pk_bf16(float lo, float hi) { unsigned r; asm("v_cvt_pk_bf16_f32 %0, %1, %2" : "=v"(r) : "v"(lo), "v"(hi)); return r; }
DI float bf_lo(unsigned u) { return __uint_as_float(u << 16); }
DI float bf_hi(unsigned u) { return __uint_as_float(u & 0xffff0000u); }
DI float bf2f(bf16_t v) { return __uint_as_float(((unsigned)v) << 16); }
DI float wave_sum(float v) {
    v += __shfl_xor(v, 32); v += __shfl_xor(v, 16); v += __shfl_xor(v, 8); v += __shfl_xor(v, 4); v += __shfl_xor(v, 2); v += __shfl_xor(v, 1);
    return v;
}
DI float fexp2(float x) { return __builtin_amdgcn_exp2f(x); }
DI int otid() { int t = threadIdx.x; asm volatile("" : "+v"(t)); return t; }

#define XB_TMO      128
#define XB_XCNT(j)  (256  + 64 * (j))
#define XB_XSUB(j)  (1280 + 64 * (j))
#define XB_XGEN(j)  (2304 + 64 * (j))
#define XB_TOP      3328
#define XB_TOPGEN   3392
#define XCD_BAR_WORDS 3456
#define XB_SPIN_CAP (1u << 24)
DI unsigned xb_ld(unsigned* p) { return __hip_atomic_load(p, __ATOMIC_RELAXED, __HIP_MEMORY_SCOPE_AGENT); }
DI unsigned xb_add(unsigned* p, unsigned v) { return __hip_atomic_fetch_add(p, v, __ATOMIC_RELAXED, __HIP_MEMORY_SCOPE_AGENT); }
DI unsigned xb_xcc_id() { return (unsigned)__builtin_amdgcn_s_getreg((3 << 11) | 20) & 0xFu; }
#define XB_SPIN(cond, bar) do { unsigned _sp = 0; while (cond) { __builtin_amdgcn_s_sleep(1); \
    if ((++_sp & 255u) == 0u) { if (xb_ld(&(bar)[XB_TMO])) break; if (_sp > XB_SPIN_CAP) { atomicAdd(&(bar)[XB_TMO], 1u); break; } } } } while (0)
struct XcdBarrier { unsigned* bar; unsigned x; volatile LAS unsigned* st; };
DI XcdBarrier xcd_barrier_post(unsigned* bar, volatile LAS unsigned* st) {
    XcdBarrier b; b.bar = bar; b.x = xb_xcc_id(); b.st = st;
    if (threadIdx.x == 0) (void)xb_add(&bar[XB_XCNT(b.x)], 1u);
    return b;
}
DI void xcd_barrier_complete(unsigned* bar, unsigned x, unsigned& nloc, unsigned& nx) {
    const unsigned G = gridDim.x * gridDim.y * gridDim.z;
    unsigned sum, cnt, mine, sp = 0u;
    for (;;) {
        sum = 0u; cnt = 0u; mine = 0u;
#pragma unroll
        for (unsigned j = 0; j < 16; ++j) { const unsigned c = xb_ld(&bar[XB_XCNT(j)]); sum += c; cnt += (c > 0u) ? 1u : 0u; mine = (j == x) ? c : mine; }
        if (sum == G) break;
        __builtin_amdgcn_s_sleep(1);
        if ((++sp & 255u) == 0u) { if (xb_ld(&bar[XB_TMO])) break; if (sp > XB_SPIN_CAP) { atomicAdd(&bar[XB_TMO], 1u); break; } }
    }
    nloc = mine > 0u ? mine : 1u; nx = cnt > 0u ? cnt : 1u;
}
#ifndef USE_CG_SYNC
#define USE_CG_SYNC 0
#endif
DI void xcd_barrier(const XcdBarrier& b) {
#if USE_CG_SYNC
    (void)b; cg::this_grid().sync(); return;
#endif
    asm volatile("s_waitcnt vmcnt(0)" ::: "memory");
    __syncthreads();
    if (threadIdx.x == 0) {
        unsigned* bar = b.bar;
        __builtin_amdgcn_s_waitcnt(0);
        unsigned nloc = b.st[0], nx = b.st[1];
        if (nloc == 0u) { xcd_barrier_complete(bar, b.x, nloc, nx); b.st[0] = nloc; b.st[1] = nx; }
        const unsigned old = xb_add(&bar[XB_XSUB(b.x)], 1u);
        const unsigned gen = old / nloc;
        if (old + 1u == (gen + 1u) * nloc) {
            __builtin_amdgcn_fence(__ATOMIC_RELEASE, "agent");
            asm volatile("s_waitcnt vmcnt(0)" ::: "memory");
            const unsigned og = xb_add(&bar[XB_TOP], 1u);
            const unsigned tg = og / nx;
            if (og + 1u == (tg + 1u) * nx) xb_add(&bar[XB_TOPGEN], 1u);
            else XB_SPIN(xb_ld(&bar[XB_TOPGEN]) == tg, bar);
            __builtin_amdgcn_fence(__ATOMIC_ACQUIRE, "agent");
            xb_add(&bar[XB_XGEN(b.x)], 1u);
            asm volatile("s_waitcnt vmcnt(0)" ::: "memory");
        } else {
            XB_SPIN(xb_ld(&bar[XB_XGEN(b.x)]) == gen, bar);
            __builtin_amdgcn_fence(__ATOMIC_ACQUIRE, "agent");
            asm volatile("s_waitcnt vmcnt(0)" ::: "memory");
        }
    }
    __syncthreads();
}

DI void transpose_tile(const float* __restrict__ W, int K, int N, int Npad, bf16_t* __restrict__ Wt, int tile, float* tl) {
    const int ntn = Npad >> 6, kt = tile / ntn, nt = tile - kt * ntn, k0 = kt << 6, n0 = nt << 6;
    const int tid_ = otid(); const int tx = tid_ & 63, ty = tid_ >> 6;
#pragma unroll 4
    for (int r = 0; r < 16; ++r) { const int k = k0 + ty + 4 * r, n = n0 + tx; tl[(ty + 4 * r) * 65 + tx] = (n < N) ? W[(size_t)k * N + n] : 0.f; }
    __syncthreads();
#pragma unroll 4
    for (int r = 0; r < 16; ++r) { const int nl = ty + 4 * r; Wt[(size_t)(n0 + nl) * K + k0 + tx] = (bf16_t)(pk_bf16(tl[tx * 65 + nl], 0.f) & 0xffffu); }
    __syncthreads();
}
DI void phase_prologue(const Params& p, unsigned char* smem) {
    float* tl = (float*)smem;
    constexpr int PER_LAYER = 2984;
    for (int t = blockIdx.x; t < DEPTH * PER_LAYER; t += gridDim.x) {
        const int l = t / PER_LAYER; int r = t - l * PER_LAYER;
        if (r < 640) transpose_tile(p.w_in + (size_t)l * DM * INW, DM, INW, PLD, (bf16_t*)(p.ws + WS_WIN) + (size_t)l * PLD * DM, r, tl);
        else if (r < 664) transpose_tile(p.w_q_up + (size_t)l * 256 * 384, 256, 384, 384, (bf16_t*)(p.ws + WS_WQUP) + (size_t)l * 384 * 256, r - 640, tl);
        else if (r < 680) transpose_tile(p.w_kv_up + (size_t)l * 128 * 512, 128, 512, 512, (bf16_t*)(p.ws + WS_WKVUP) + (size_t)l * 512 * 128, r - 664, tl);
        else if (r < 936) transpose_tile(p.w_out + (size_t)l * DM * DM, DM, DM, DM, (bf16_t*)(p.ws + WS_WOUT) + (size_t)l * DM * DM, r - 680, tl);
        else if (r < 1960) transpose_tile(p.w_mlp_up + (size_t)l * DM * DFF, DM, DFF, DFF, (bf16_t*)(p.ws + WS_WUP) + (size_t)l * DFF * DM, r - 936, tl);
        else transpose_tile(p.w_mlp_down + (size_t)l * DFF * DM, DFF, DM, DM, (bf16_t*)(p.ws + WS_WDOWN) + (size_t)l * DM * DFF, r - 1960, tl);
    }
    float* rc = (float*)(p.ws + WS_ROPE); float* rs = rc + 16384 * 16;
    for (int idx = blockIdx.x * 256 + otid(); idx < 16384 * 16; idx += gridDim.x * 256) {
        const int pos = idx >> 4, i = idx & 15;
        const double invf = exp2(-(double)i * (13.287712379549449 / 16.0)) * 0.15915494309189535;
        const double rev = (double)pos * invf;
        const double fr = rev - floor(rev);
        const float ang = (float)(fr * 6.283185307179586);
        rc[idx] = cosf(ang); rs[idx] = sinf(ang);
    }
}

DI void phase_rmsnorm_to_bf16(const float* __restrict__ x, const float* __restrict__ g, bf16_t* __restrict__ out, int rows) {
    const int tid_ = otid(); const int wave = tid_ >> 6, lane = tid_ & 63;
    for (int row = blockIdx.x * 4 + wave; row < rows; row += gridDim.x * 4) {
        const float4* xr = (const float4*)(x + (size_t)row * DM);
        float4 v[4]; float ss = 0.f;
#pragma unroll
        for (int i = 0; i < 4; ++i) { v[i] = xr[lane + 64 * i]; ss += v[i].x * v[i].x + v[i].y * v[i].y + v[i].z * v[i].z + v[i].w * v[i].w; }
        ss = wave_sum(ss);
        const float rs = rsqrtf(ss * (1.0f / DM) + EPS);
#pragma unroll
        for (int i = 0; i < 4; ++i) {
            const float4 gg = ((const float4*)g)[lane + 64 * i];
            u32x2 o; o.x = pk_bf16(v[i].x * rs * gg.x, v[i].y * rs * gg.y); o.y = pk_bf16(v[i].z * rs * gg.z, v[i].w * rs * gg.w);
            *(u32x2*)(out + (size_t)row * DM + 4 * (lane + 64 * i)) = o;
        }
    }
}
DI void phase_final_norm(float* __restrict__ x, const float* __restrict__ g, int rows) {
    const int tid_ = otid(); const int wave = tid_ >> 6, lane = tid_ & 63;
    for (int row = blockIdx.x * 4 + wave; row < rows; row += gridDim.x * 4) {
        float4* xr = (float4*)(x + (size_t)row * DM);
        float4 v[4]; float ss = 0.f;
#pragma unroll
        for (int i = 0; i < 4; ++i) { v[i] = xr[lane + 64 * i]; ss += v[i].x * v[i].x + v[i].y * v[i].y + v[i].z * v[i].z + v[i].w * v[i].w; }
        ss = wave_sum(ss);
        const float rs = rsqrtf(ss * (1.0f / DM) + EPS);
#pragma unroll
        for (int i = 0; i < 4; ++i) {
            const float4 gg = ((const float4*)g)[lane + 64 * i];
            float4 o; o.x = v[i].x * rs * gg.x; o.y = v[i].y * rs * gg.y; o.z = v[i].z * rs * gg.z; o.w = v[i].w * rs * gg.w;
            xr[lane + 64 * i] = o;
        }
    }
}
DI void phase_group_norm(bf16_t* __restrict__ o, const float* __restrict__ g, int rows) {
    const int tid_ = otid(); const int wave = tid_ >> 6, lane = tid_ & 63;
    for (int row = blockIdx.x * 4 + wave; row < rows; row += gridDim.x * 4) {
        u32x4* pr = (u32x4*)(o + (size_t)row * DM) + 2 * lane;
        const u32x4 a = pr[0], b = pr[1];
        float f[16];
#pragma unroll
        for (int j = 0; j < 4; ++j) { f[2 * j] = bf_lo(a[j]); f[2 * j + 1] = bf_hi(a[j]); f[8 + 2 * j] = bf_lo(b[j]); f[8 + 2 * j + 1] = bf_hi(b[j]); }
        float ss = 0.f;
#pragma unroll
        for (int j = 0; j < 16; ++j) ss += f[j] * f[j];
        ss += __shfl_xor(ss, 8); ss += __shfl_xor(ss, 4); ss += __shfl_xor(ss, 2); ss += __shfl_xor(ss, 1);
        const float rs = rsqrtf(ss * (1.0f / 256.0f) + EPS);
        const float4* gp = (const float4*)(g + 16 * lane);
        u32x4 oa, ob;
#pragma unroll
        for (int j = 0; j < 2; ++j) {
            const float4 g0 = gp[j];
            oa[2 * j] = pk_bf16(f[4 * j] * rs * g0.x, f[4 * j + 1] * rs * g0.y); oa[2 * j + 1] = pk_bf16(f[4 * j + 2] * rs * g0.z, f[4 * j + 3] * rs * g0.w);
            const float4 g1 = gp[2 + j];
            ob[2 * j] = pk_bf16(f[8 + 4 * j] * rs * g1.x, f[8 + 4 * j + 1] * rs * g1.y); ob[2 * j + 1] = pk_bf16(f[8 + 4 * j + 2] * rs * g1.z, f[8 + 4 * j + 3] * rs * g1.w);
        }
        pr[0] = oa; pr[1] = ob;
    }
}
DI void phase_mla_prep(const Params& p, int l, int S) {
    const int tid_ = otid(); const int wave = tid_ >> 6, lane = tid_ & 63;
    bf16_t* proj = (bf16_t*)(p.ws + WS_PROJ);
    const float* qn = p.mla_q_norm + l * 256; const float* kn = p.mla_kv_norm + l * 128;
    const float* rc = (const float*)(p.ws + WS_ROPE); const float* rsn = rc + 16384 * 16;
    for (int tok = blockIdx.x * 4 + wave; tok < TC; tok += gridDim.x * 4) {
        bf16_t* row = proj + (size_t)tok * PLD;
        const int pos = tok & (S - 1);
        const u32x2 cq = *(const u32x2*)(row + OFF_CQ + 4 * lane);
        const unsigned ckv = *(const unsigned*)(row + OFF_CKV + 2 * lane);
        float x1 = 0.f, x2 = 0.f;
        if (lane < 16) { x1 = bf2f(row[OFF_CKR + lane]); x2 = bf2f(row[OFF_CKR + 16 + lane]); }
        const float q0 = bf_lo(cq.x), q1 = bf_hi(cq.x), q2 = bf_lo(cq.y), q3 = bf_hi(cq.y);
        const float k0 = bf_lo(ckv), k1 = bf_hi(ckv);
        const float sq = wave_sum(q0 * q0 + q1 * q1 + q2 * q2 + q3 * q3);
        const float sk = wave_sum(k0 * k0 + k1 * k1);
        const float rq = rsqrtf(sq * (1.0f / 256.0f) + EPS), rk = rsqrtf(sk * (1.0f / 128.0f) + EPS);
        const float4 gq = *(const float4*)(qn + 4 * lane); const float2 gk = *(const float2*)(kn + 2 * lane);
        u32x2 oq; oq.x = pk_bf16(q0 * rq * gq.x, q1 * rq * gq.y); oq.y = pk_bf16(q2 * rq * gq.z, q3 * rq * gq.w);
        *(u32x2*)((bf16_t*)(p.ws + WS_CQN) + (size_t)tok * 256 + 4 * lane) = oq;
        *(unsigned*)((bf16_t*)(p.ws + WS_CKVN) + (size_t)tok * 128 + 2 * lane) = pk_bf16(k0 * rk * gk.x, k1 * rk * gk.y);
        if (lane < 16) {
            const float c = rc[pos * 16 + lane], s = rsn[pos * 16 + lane];
            const unsigned o = pk_bf16(x1 * c - x2 * s, x1 * s + x2 * c);
            bf16_t* kp = (bf16_t*)(p.ws + WS_KPE) + (size_t)tok * 32;
            kp[lane] = (bf16_t)(o & 0xffffu); kp[16 + lane] = (bf16_t)(o >> 16);
        }
    }
}

constexpr int G_BK = 64;
constexpr int G_LDS_ROW = 64;
constexpr int G_TILE_ELEMS = 128 * G_LDS_ROW;
struct GemmArgs { const bf16_t* A; int lda; const bf16_t* Bt; int ldb; int K; };

struct EpiBf16 { bf16_t* C; int ldc;
    DI void operator()(int m, int n, const f32x16& v) const {
        u32x4 o0, o1;
#pragma unroll
        for (int j = 0; j < 4; ++j) { o0[j] = pk_bf16(v[2 * j], v[2 * j + 1]); o1[j] = pk_bf16(v[8 + 2 * j], v[8 + 2 * j + 1]); }
        u32x4* d = (u32x4*)(C + (size_t)m * ldc + n); d[0] = o0; d[1] = o1; } };
struct EpiRelu2 { bf16_t* C; int ldc;
    DI void operator()(int m, int n, const f32x16& v) const {
        float t[16];
#pragma unroll
        for (int e = 0; e < 16; ++e) { const float a = fmaxf(v[e], 0.f); t[e] = a * a; }
        u32x4 o0, o1;
#pragma unroll
        for (int j = 0; j < 4; ++j) { o0[j] = pk_bf16(t[2 * j], t[2 * j + 1]); o1[j] = pk_bf16(t[8 + 2 * j], t[8 + 2 * j + 1]); }
        u32x4* d = (u32x4*)(C + (size_t)m * ldc + n); d[0] = o0; d[1] = o1; } };
struct EpiResid { const float* xin; float* xout;
    DI void operator()(int m, int n, const f32x16& v) const {
        const float4* s = (const float4*)(xin + (size_t)m * DM + n); float4* d = (float4*)(xout + (size_t)m * DM + n);
#pragma unroll
        for (int q = 0; q < 4; ++q) { const float4 r = s[q]; float4 o; o.x = r.x + v[4 * q]; o.y = r.y + v[4 * q + 1]; o.z = r.z + v[4 * q + 2]; o.w = r.w + v[4 * q + 3]; d[q] = o; } } };

template <class Epi>
DI void gemm_tile(const GemmArgs& g, int m0, int n0, const Epi& epi, unsigned char* smem) {
    bf16_t* As = (bf16_t*)smem; bf16_t* Bs = As + G_TILE_ELEMS;
    const int tid = otid(), lane = tid & 63, wave = tid >> 6, wm = wave >> 1, wn = wave & 1, r = lane & 31, hh = lane >> 5;
    const int lrow = tid >> 3, lch = tid & 7;
    const bf16_t* ga = g.A + (size_t)(m0 + lrow) * g.lda + lch * 8;
    const bf16_t* gb = g.Bt + (size_t)(n0 + lrow) * g.ldb + lch * 8;
    const size_t sa = (size_t)32 * g.lda, sb = (size_t)32 * g.ldb;
    int wofs[4];
#pragma unroll
    for (int i = 0; i < 4; ++i) { const int row = lrow + 32 * i; wofs[i] = row * G_LDS_ROW + ((lch ^ ((row >> 1) & 7)) << 3); }
    f32x16 acc[2][2];
#pragma unroll
    for (int i = 0; i < 2; ++i)
#pragma unroll
        for (int j = 0; j < 2; ++j)
#pragma unroll
            for (int e = 0; e < 16; ++e) acc[i][j][e] = 0.f;
    u32x4 ra[4], rb[4];
    const int KT = g.K / G_BK;
    const int rsw = (r >> 1) & 7;
    const int nperm = 16 * ((r >> 2) & 1) + 4 * (r >> 3) + (r & 3), rswb = (nperm >> 1) & 7;
    const bf16_t* Abase = As + (64 * wm + r) * G_LDS_ROW;
    const bf16_t* Bbase = Bs + (64 * wn + nperm) * G_LDS_ROW;
    __syncthreads();
#pragma unroll
    for (int i = 0; i < 4; ++i) { ra[i] = *(const u32x4*)(ga + i * sa); rb[i] = *(const u32x4*)(gb + i * sb); }
#pragma unroll
    for (int i = 0; i < 4; ++i) { *(u32x4*)(As + wofs[i]) = ra[i]; *(u32x4*)(Bs + wofs[i]) = rb[i]; }
    __syncthreads();
#pragma unroll 1
    for (int kt = 0; kt < KT; ++kt) {
        if (kt + 1 < KT) {
            const int k0 = (kt + 1) * G_BK;
#pragma unroll
            for (int i = 0; i < 4; ++i) { ra[i] = *(const u32x4*)(ga + i * sa + k0); rb[i] = *(const u32x4*)(gb + i * sb + k0); }
        }
        __builtin_amdgcn_s_setprio(1);
#pragma unroll
        for (int kk = 0; kk < G_BK / 16; ++kk) {
            const int pc = ((2 * kk + hh) ^ rsw) << 3, pcb = ((2 * kk + hh) ^ rswb) << 3;
            bf16x8 af[2], bfr[2];
#pragma unroll
            for (int i = 0; i < 2; ++i) { af[i] = *(const bf16x8*)(Abase + 32 * i * G_LDS_ROW + pc); bfr[i] = *(const bf16x8*)(Bbase + 32 * i * G_LDS_ROW + pcb); }
#pragma unroll
            for (int i = 0; i < 2; ++i)
#pragma unroll
                for (int j = 0; j < 2; ++j) acc[i][j] = __builtin_amdgcn_mfma_f32_32x32x16_bf16(bfr[j], af[i], acc[i][j], 0, 0, 0);
        }
        __builtin_amdgcn_s_setprio(0);
        __syncthreads();
        if (kt + 1 < KT) {
#pragma unroll
            for (int i = 0; i < 4; ++i) { *(u32x4*)(As + wofs[i]) = ra[i]; *(u32x4*)(Bs + wofs[i]) = rb[i]; }
        }
        __syncthreads();
    }
#pragma unroll
    for (int i = 0; i < 2; ++i)
#pragma unroll
        for (int j = 0; j < 2; ++j)
            epi(m0 + 64 * wm + 32 * i + r, n0 + 64 * wn + 32 * j + 16 * hh, acc[i][j]);
}
DI void tile_map(int t, int n_mt, int n_nt, int& mt, int& nt) {
#if TRIVIAL_MAP
    (void)n_mt; mt = t / n_nt; nt = t - mt * n_nt;
#else
    const int x = t & 7, j = t >> 3, mpx = n_mt >> 3, gsz = TILE_GM * n_nt;
    const int gi = j / gsz, rem = j - gi * gsz;
    mt = x * mpx + gi * TILE_GM + (rem % TILE_GM); nt = rem / TILE_GM;
#endif
}
template <class Epi>
DI void phase_gemm(const GemmArgs& g, int M, int N, const Epi& epi, unsigned char* smem) {
    const int n_mt = M >> 7, n_nt = N >> 7, total = n_mt * n_nt;
#pragma unroll 1
    for (int t = blockIdx.x; t < total; t += gridDim.x) { int mt, nt; tile_map(t, n_mt, n_nt, mt, nt); gemm_tile(g, mt << 7, nt << 7, epi, smem); }
}

constexpr int C_KROW = 104;
constexpr int C_KBYTES = 64 * C_KROW * 2;
constexpr int C_VBYTES = 2 * 64 * 64;
constexpr int C_BUF = C_KBYTES + C_VBYTES;
DI void attn_c_item(const Params& p, int S, int item, unsigned char* smem) {
#if (PH_MASK & 8192)
    {
        const int tid = otid(); const int nqt = S >> 7;
        const int qt = item % nqt; const int h = (item / nqt) & 3; const int seq = item / (nqt * 4);
        const bf16_t* proj = (const bf16_t*)(p.ws + WS_PROJ); const bf16_t* qc = (const bf16_t*)(p.ws + WS_QC); const bf16_t* kvc = (const bf16_t*)(p.ws + WS_KVC);
        bf16_t* ob = (bf16_t*)(p.ws + WS_H);
        for (int e = tid; e < 128 * 64; e += 256) {
            const int tok = seq * S + qt * 128 + (e >> 6), d = e & 63;
            const float v = bf2f(qc[(size_t)tok * 384 + h * 96 + d]) + bf2f(qc[(size_t)tok * 384 + h * 96 + 32 + d]) + bf2f(kvc[(size_t)tok * 512 + h * 128 + d]) + bf2f(kvc[(size_t)tok * 512 + h * 128 + 64 + d]) + bf2f(((const bf16_t*)(p.ws + WS_KPE))[(size_t)tok * 32 + (d & 31)]);
            ob[(size_t)tok * DM + 512 + h * 64 + d] = (bf16_t)(pk_bf16(v, 0.f) & 0xffffu);
        }
        return;
    }
#endif
    const int tid = otid(), lane = tid & 63, wave = tid >> 6, r = lane & 31, hh = lane >> 5;
    const int nqt = S >> 7;
    const int qt = item % nqt; const int h = (item / nqt) & 3; const int seq = item / (nqt * 4);
    const int seqbase = seq * S;
    const bf16_t* proj = (const bf16_t*)(p.ws + WS_PROJ);
    const bf16_t* qc = (const bf16_t*)(p.ws + WS_QC);
    const bf16_t* kvc = (const bf16_t*)(p.ws + WS_KVC);
    bf16_t* ob = (bf16_t*)(p.ws + WS_H);
    const float* rc = (const float*)(p.ws + WS_ROPE); const float* rsn = rc + 16384 * 16;
    constexpr float QSC = 0.10206207261596577f * LOG2E;
    const int qpos = qt * 128 + wave * 32 + r; const int qtok = seqbase + qpos;
    bf16x8 qf[6];
    {
        const bf16_t* qrow = qc + (size_t)qtok * 384 + h * 96;
#pragma unroll
        for (int kk = 0; kk < 4; ++kk) {
            const u32x4 qv = *(const u32x4*)(qrow + 16 * kk + 8 * hh); u32x4 qs;
#pragma unroll
            for (int j = 0; j < 4; ++j) qs[j] = pk_bf16(bf_lo(qv[j]) * QSC, bf_hi(qv[j]) * QSC);
            qf[kk] = __builtin_bit_cast(bf16x8, qs);
        }
        const u32x4 x1 = *(const u32x4*)(qrow + 64 + 8 * hh), x2 = *(const u32x4*)(qrow + 80 + 8 * hh);
        const float4 c0 = *(const float4*)(rc + qpos * 16 + 8 * hh), c1 = *(const float4*)(rc + qpos * 16 + 8 * hh + 4);
        const float4 s0 = *(const float4*)(rsn + qpos * 16 + 8 * hh), s1 = *(const float4*)(rsn + qpos * 16 + 8 * hh + 4);
        const float cs[8] = {c0.x, c0.y, c0.z, c0.w, c1.x, c1.y, c1.z, c1.w};
        const float sn[8] = {s0.x, s0.y, s0.z, s0.w, s1.x, s1.y, s1.z, s1.w};
        u32x4 o1, o2;
#pragma unroll
        for (int j = 0; j < 4; ++j) {
            const float a0 = bf_lo(x1[j]), a1 = bf_hi(x1[j]), b0 = bf_lo(x2[j]), b1 = bf_hi(x2[j]);
            o1[j] = pk_bf16((a0 * cs[2 * j] - b0 * sn[2 * j]) * QSC, (a1 * cs[2 * j + 1] - b1 * sn[2 * j + 1]) * QSC);
            o2[j] = pk_bf16((a0 * sn[2 * j] + b0 * cs[2 * j]) * QSC, (a1 * sn[2 * j + 1] + b1 * cs[2 * j + 1]) * QSC);
        }
        qf[4] = __builtin_bit_cast(bf16x8, o1); qf[5] = __builtin_bit_cast(bf16x8, o2);
    }
    const int lkey = tid >> 3, lch = tid & 7;
    const int pkey = tid >> 2, pch = tid & 3;
    const bf16_t* gkv = kvc + (size_t)(seqbase + lkey) * 512 + h * 128 + 8 * lch;
    const bf16_t* gpe = (const bf16_t*)(p.ws + WS_KPE) + (size_t)(seqbase + pkey) * 32 + 8 * pch;
    const int dk0 = lkey * (C_KROW * 2) + lch * 16;
    const int dv0 = C_KBYTES + (lch >> 2) * 4096 + lkey * 64 + (lch & 3) * 16;
    const int dp0 = pkey * (C_KROW * 2) + 128 + pch * 16;
    u32x4 rg[5];
    const int nkt = S >> 6;
    const float cscale = 0.10206207261596577f * LOG2E;
    float m_run = 0.f, l_run = 0.f;
    f32x16 o[2];
#pragma unroll
    for (int e = 0; e < 16; ++e) { o[0][e] = 0.f; o[1][e] = 0.f; }
    __syncthreads();
#define C_LOAD(kt_) do { const size_t ko = (size_t)(kt_) * 64; \
        rg[0] = *(const u32x4*)(gkv + ko * 512); rg[1] = *(const u32x4*)(gkv + (ko + 32) * 512); \
        rg[2] = *(const u32x4*)(gkv + ko * 512 + 64); rg[3] = *(const u32x4*)(gkv + (ko + 32) * 512 + 64); \
        rg[4] = *(const u32x4*)(gpe + ko * 32); } while (0)
#define C_STORE(b_) do { unsigned char* bb = smem + (b_) * C_BUF; \
        *(u32x4*)(bb + dk0) = rg[0]; *(u32x4*)(bb + dk0 + 32 * C_KROW * 2) = rg[1]; \
        *(u32x4*)(bb + dv0) = rg[2]; *(u32x4*)(bb + dv0 + 32 * 64) = rg[3]; \
        *(u32x4*)(bb + dp0) = rg[4]; } while (0)
    C_LOAD(0); C_STORE(0);
    __syncthreads();
    const int sg = lane >> 4, li = lane & 15;
    const int vrd = ((sg >> 1) * 4 + (li >> 2)) * 64 + ((sg & 1) * 16 + (li & 3) * 4) * 2;
#pragma unroll 1
    for (int kt = 0; kt < nkt; ++kt) {
        const int buf = kt & 1;
        if (kt + 1 < nkt) C_LOAD(kt + 1);
        const unsigned char* kb = smem + buf * C_BUF;
        const unsigned char* vb = kb + C_KBYTES;
        f32x16 s[2];
#pragma unroll
        for (int st = 0; st < 2; ++st) {
#pragma unroll
            for (int e = 0; e < 16; ++e) s[st][e] = -m_run;
#pragma unroll
            for (int kk = 0; kk < 6; ++kk) {
                const bf16x8 kf = *(const bf16x8*)(kb + (32 * st + r) * (C_KROW * 2) + (16 * kk + 8 * hh) * 2);
                s[st] = __builtin_amdgcn_mfma_f32_32x32x16_bf16(kf, qf[kk], s[st], 0, 0, 0);
            }
        }
        float mx = fmaxf(s[0][0], s[1][0]);
#pragma unroll
        for (int e = 1; e < 16; ++e) mx = fmaxf(mx, fmaxf(s[0][e], s[1][e]));
        { const auto sw = __builtin_amdgcn_permlane32_swap(__float_as_uint(mx), __float_as_uint(mx), false, false); mx = fmaxf(__uint_as_float(sw[0]), __uint_as_float(sw[1])); }
        if (__any(mx > 0.f)) {
            const float up = fmaxf(mx, 0.f), alpha = fexp2(-up);
#pragma unroll
            for (int e = 0; e < 16; ++e) { o[0][e] *= alpha; o[1][e] *= alpha; s[0][e] -= up; s[1][e] -= up; }
            l_run *= alpha; m_run += up;
        }
#pragma unroll
        for (int st = 0; st < 2; ++st) {
            float pe[16]; float ls = 0.f;
#pragma unroll
            for (int e = 0; e < 16; ++e) { pe[e] = fexp2(s[st][e]); ls += pe[e]; }
            l_run += ls;
            u32x4 p0, p1;
#pragma unroll
            for (int j = 0; j < 4; ++j) { p0[j] = pk_bf16(pe[2 * j], pe[2 * j + 1]); p1[j] = pk_bf16(pe[8 + 2 * j], pe[8 + 2 * j + 1]); }
            const bf16x8 pf0 = __builtin_bit_cast(bf16x8, p0), pf1 = __builtin_bit_cast(bf16x8, p1);
#pragma unroll
            for (int db = 0; db < 2; ++db) {
#pragma unroll
                for (int s2 = 0; s2 < 2; ++s2) {
                    const unsigned char* va = vb + db * 4096 + (32 * st + 16 * s2) * 64 + vrd;
                    const s16x4 t0 = __builtin_amdgcn_ds_read_tr16_b64_v4i16((LAS s16x4*)(va));
                    const s16x4 t1 = __builtin_amdgcn_ds_read_tr16_b64_v4i16((LAS s16x4*)(va + 8 * 64));
                    const bf16x8 vf = {t0[0], t0[1], t0[2], t0[3], t1[0], t1[1], t1[2], t1[3]};
                    o[db] = __builtin_amdgcn_mfma_f32_32x32x16_bf16(vf, s2 ? pf1 : pf0, o[db], 0, 0, 0);
                }
            }
        }
        if (kt + 1 < nkt) C_STORE(buf ^ 1);
        __syncthreads();
    }
#undef C_LOAD
#undef C_STORE
    const float lt = l_run + __shfl_xor(l_run, 32);
    const float inv = 1.0f / lt;
    bf16_t* orow = ob + (size_t)qtok * DM + 512 + h * 64;
#pragma unroll
    for (int db = 0; db < 2; ++db)
#pragma unroll
        for (int q4 = 0; q4 < 4; ++q4) {
            u32x2 w; w.x = pk_bf16(o[db][4 * q4] * inv, o[db][4 * q4 + 1] * inv); w.y = pk_bf16(o[db][4 * q4 + 2] * inv, o[db][4 * q4 + 3] * inv);
            *(u32x2*)(orow + 32 * db + 8 * q4 + 4 * hh) = w;
        }
}

constexpr int SM_VROW = 72;
struct SmallItem {
    int mode;
    int S, seqbase, h;
    int q0, qstride;
    int ntiles;
    int rowstart, cs, r;
    float slope2;
    const float* rpb;
};
DI int small_keypos(const SmallItem& it, int t, int kidx) {
    if (it.mode == 0) {
        if (t < 12) return it.q0 - 64 + 32 * t + kidx;
        if (t < 18) return it.q0 - 256 + 4 * (32 * (t - 12) + kidx);
        return it.q0 - 1024 + 16 * (32 * (t - 18) + kidx);
    } else if (it.mode == 1) {
        return it.q0 - 128 + 32 * t + kidx;
    } else {
        return (it.rowstart + t) * 64 + it.cs + kidx;
    }
}
DI float small_bias(const SmallItem& it, int t, int kp, int qp) {
    const float NINF = -__builtin_inff();
    if (it.mode == 0) {
        const int W = t < 12 ? 64 : (t < 18 ? 256 : 1024);
        const int d = kp > qp ? kp - qp : qp - kp;
        return (kp >= 0 && kp < it.S && d <= W) ? -it.slope2 * (float)d : NINF;
    } else if (it.mode == 1) {
        const int d = kp > qp ? kp - qp : qp - kp;
        return (kp >= 0 && kp < it.S && d <= 128) ? -it.slope2 * (float)d : NINF;
    } else {
        const int kc = kp & 63, qc = qp & 63;
        int cst = qc - 8; cst = cst < 0 ? 0 : (cst > 48 ? 48 : cst);
        int dc = kc - qc; dc = dc < -15 ? -15 : (dc > 15 ? 15 : dc);
        const int dr = it.rowstart + t - it.r + 7;
        const float b = it.rpb[dr * 31 + dc + 15] * LOG2E;
        return (kc >= cst && kc < cst + 16) ? b : NINF;
    }
}
DI void small_attn_item(const Params& p, const SmallItem& it, int qoff, int koff, int voff, int ooff, float sink2, bool has_sink, bf16_t* vs  ) {
    const int lane = otid() & 63, li = lane & 15, g = lane >> 4;
    const bf16_t* proj = (const bf16_t*)(p.ws + WS_PROJ);
    bf16_t* ob = (bf16_t*)(p.ws + WS_H);
    const int qp = it.q0 + li * it.qstride;
    const int qtok = it.seqbase + qp;
    bf16x8 qf[2];
    qf[0] = *(const bf16x8*)(proj + (size_t)qtok * PLD + qoff + 8 * g);
    qf[1] = *(const bf16x8*)(proj + (size_t)qtok * PLD + qoff + 32 + 8 * g);
    const int key_a = 8 * (li >> 2) + (li & 3);
    float m_run = has_sink ? sink2 : -__builtin_inff();
    float l_run = (has_sink && g == 0) ? 1.0f : 0.f;
    f32x4 o[4];
#pragma unroll
    for (int db = 0; db < 4; ++db) o[db] = (f32x4){0.f, 0.f, 0.f, 0.f};
    const float sc2 = 0.125f * LOG2E;
    const float NINF = -__builtin_inff();
    int dci[8]; bool dva[8];
    {
        const int qc = qp & 63; int cst = qc - 8; cst = cst < 0 ? 0 : (cst > 48 ? 48 : cst);
#pragma unroll
        for (int e = 0; e < 8; ++e) { const int kc = it.cs + 8 * g + e; int dc = kc - qc; dc = dc < -15 ? -15 : (dc > 15 ? 15 : dc); dci[e] = dc + 15; dva[e] = (kc >= cst) && (kc < cst + 16); }
    }
    for (int t = 0; t < it.ntiles; t += 2) {
        bf16x8 kf[2][4]; u32x4 vr[2][4];
#pragma unroll
        for (int u = 0; u < 2; ++u) {
            const int tt = t + u; int tbase, tstride;
            if (it.mode == 0) { if (tt < 12) { tbase = it.q0 - 64 + 32 * tt; tstride = 1; } else if (tt < 18) { tbase = it.q0 - 256 + 128 * (tt - 12); tstride = 4; } else { tbase = it.q0 - 1024 + 512 * (tt - 18); tstride = 16; } }
            else if (it.mode == 1) { tbase = it.q0 - 128 + 32 * tt; tstride = 1; }
            else { tbase = (it.rowstart + tt) * 64 + it.cs; tstride = 1; }
            int ka = tbase + tstride * key_a, kb = tbase + tstride * (key_a + 4);
            ka = ka < 0 ? 0 : (ka > it.S - 1 ? it.S - 1 : ka); kb = kb < 0 ? 0 : (kb > it.S - 1 ? it.S - 1 : kb);
            const bf16_t* kra = proj + (size_t)(it.seqbase + ka) * PLD + koff + 8 * g;
            const bf16_t* krb = proj + (size_t)(it.seqbase + kb) * PLD + koff + 8 * g;
            kf[u][0] = *(const bf16x8*)(kra); kf[u][1] = *(const bf16x8*)(kra + 32); kf[u][2] = *(const bf16x8*)(krb); kf[u][3] = *(const bf16x8*)(krb + 32);
#pragma unroll
            for (int n = 0; n < 4; ++n) {
                const int c = lane + 64 * n, key = c >> 3, dch = c & 7;
                int kp = tbase + tstride * key; kp = kp < 0 ? 0 : (kp > it.S - 1 ? it.S - 1 : kp);
                vr[u][n] = *(const u32x4*)(proj + (size_t)(it.seqbase + kp) * PLD + voff + 8 * dch);
            }
        }
        asm volatile("s_waitcnt lgkmcnt(0)" ::: "memory");
#pragma unroll
        for (int u = 0; u < 2; ++u)
#pragma unroll
            for (int n = 0; n < 4; ++n) { const int c = lane + 64 * n, key = c >> 3, dch = c & 7; *(u32x4*)(vs + (32 * u + key) * SM_VROW + 8 * dch) = vr[u][n]; }
        float sv[16];
#pragma unroll
        for (int u = 0; u < 2; ++u) {
            f32x4 sa = (f32x4){0.f, 0.f, 0.f, 0.f}, sb = (f32x4){0.f, 0.f, 0.f, 0.f};
            sa = __builtin_amdgcn_mfma_f32_16x16x32_bf16(kf[u][0], qf[0], sa, 0, 0, 0); sa = __builtin_amdgcn_mfma_f32_16x16x32_bf16(kf[u][1], qf[1], sa, 0, 0, 0);
            sb = __builtin_amdgcn_mfma_f32_16x16x32_bf16(kf[u][2], qf[0], sb, 0, 0, 0); sb = __builtin_amdgcn_mfma_f32_16x16x32_bf16(kf[u][3], qf[1], sb, 0, 0, 0);
            const int tt = t + u;
            if (it.mode != 2) {
                int tbase, tstride, tw;
                if (it.mode == 0) { if (tt < 12) { tbase = it.q0 - 64 + 32 * tt; tstride = 1; tw = 64; } else if (tt < 18) { tbase = it.q0 - 256 + 128 * (tt - 12); tstride = 4; tw = 256; } else { tbase = it.q0 - 1024 + 512 * (tt - 18); tstride = 16; tw = 1024; } }
                else { tbase = it.q0 - 128 + 32 * tt; tstride = 1; tw = 128; }
#pragma unroll
                for (int e = 0; e < 8; ++e) {
                    const int kp = tbase + tstride * (8 * g + e); const int dd = kp > qp ? kp - qp : qp - kp;
                    const float bias = ((unsigned)kp < (unsigned)it.S && dd <= tw) ? -it.slope2 * (float)dd : NINF;
                    sv[8 * u + e] = (e < 4 ? sa[e] : sb[e - 4]) * sc2 + bias;
                }
            } else {
                const float* rowp = it.rpb + (it.rowstart + tt - it.r + 7) * 31;
#pragma unroll
                for (int e = 0; e < 8; ++e) sv[8 * u + e] = (e < 4 ? sa[e] : sb[e - 4]) * sc2 + (dva[e] ? rowp[dci[e]] * LOG2E : NINF);
            }
        }
        float mx = sv[0];
#pragma unroll
        for (int e = 1; e < 16; ++e) mx = fmaxf(mx, sv[e]);
        mx = fmaxf(mx, __shfl_xor(mx, 16)); mx = fmaxf(mx, __shfl_xor(mx, 32));
        const float m_new = fmaxf(m_run, mx);
        const float m_use = (m_new == -__builtin_inff()) ? 0.f : m_new;
        const float alpha = fexp2(m_run - m_use);
        float pe[16]; float ls = 0.f;
#pragma unroll
        for (int e = 0; e < 16; ++e) { pe[e] = fexp2(sv[e] - m_use); ls += pe[e]; }
        l_run = l_run * alpha + ls; m_run = m_new;
#pragma unroll
        for (int db = 0; db < 4; ++db) o[db] *= alpha;
        asm volatile("s_waitcnt lgkmcnt(0)" ::: "memory");
#pragma unroll
        for (int u = 0; u < 2; ++u) {
            u32x4 pp;
#pragma unroll
            for (int j = 0; j < 4; ++j) pp[j] = pk_bf16(pe[8 * u + 2 * j], pe[8 * u + 2 * j + 1]);
            const bf16x8 pf = __builtin_bit_cast(bf16x8, pp);
#pragma unroll
            for (int db = 0; db < 4; ++db) {
                const bf16_t* va = vs + (32 * u + 8 * g + (li >> 2)) * SM_VROW + 16 * db + 4 * (li & 3);
                const s16x4 t0 = __builtin_amdgcn_ds_read_tr16_b64_v4i16((LAS s16x4*)(va));
                const s16x4 t1 = __builtin_amdgcn_ds_read_tr16_b64_v4i16((LAS s16x4*)(va + 4 * SM_VROW));
                const bf16x8 vf = {t0[0], t0[1], t0[2], t0[3], t1[0], t1[1], t1[2], t1[3]};
                o[db] = __builtin_amdgcn_mfma_f32_16x16x32_bf16(vf, pf, o[db], 0, 0, 0);
            }
        }
    }
    float lt = l_run; lt += __shfl_xor(lt, 16); lt += __shfl_xor(lt, 32);
    const float inv = 1.0f / lt;
    bf16_t* orow = ob + (size_t)qtok * DM + ooff;
#pragma unroll
    for (int db = 0; db < 4; ++db) {
        u32x2 w; w.x = pk_bf16(o[db][0] * inv, o[db][1] * inv); w.y = pk_bf16(o[db][2] * inv, o[db][3] * inv);
        *(u32x2*)(orow + 16 * db + 4 * g) = w;
    }
}
DI void small_dispatch(const Params& p, int l, int S, int wi, unsigned char* smem) {
    const int wave = __builtin_amdgcn_readfirstlane(otid() >> 6);
    wi = __builtin_amdgcn_readfirstlane(wi);
    bf16_t* vs = (bf16_t*)smem + wave * (64 * SM_VROW);
    const int mode = wi >> 13, rem = wi & 8191, h = rem >> 11, gg = rem & 2047;
    const int gps = S >> 4;
    const int seq = gg / gps, grp = gg - seq * gps;
    SmallItem it; it.mode = mode; it.S = S; it.seqbase = seq * S; it.h = h; it.rowstart = 0; it.cs = 0; it.r = 0; it.rpb = nullptr; it.slope2 = 0.f;
    if (mode == 0) {
        it.q0 = (grp >> 4) * 256 + (grp & 15); it.qstride = 16; it.ntiles = 23;
        it.slope2 = exp2f(-(float)(2 * h + 2)) * LOG2E;
        small_attn_item(p, it, OFF_AQ + 64 * h, OFF_AK + 64 * h, OFF_AV + 64 * h, 0 + 64 * h, 0.f, false, vs);
    } else if (mode == 1) {
        it.q0 = grp * 16; it.qstride = 1; it.ntiles = 9;
        it.slope2 = exp2f(-(float)(2 * h + 1)) * LOG2E;
        const float sink2 = p.sink_logits[l * 4 + h] * LOG2E;
        small_attn_item(p, it, OFF_BQ + 64 * h, OFF_BK + 64 * (h >> 1), OFF_BV + 64 * (h >> 1), 256 + 64 * h, sink2, true, vs);
    } else {
        const int rows = S >> 6; const int r = grp >> 2, c0 = (grp & 3) * 16;
        int rst = r - 4; rst = rst < 0 ? 0 : (rst > rows - 8 ? rows - 8 : rst);
        int cs = c0 - 8; cs = cs < 0 ? 0 : (cs > 32 ? 32 : cs);
        it.q0 = r * 64 + c0; it.qstride = 1; it.ntiles = 8; it.rowstart = rst; it.cs = cs; it.r = r;
        it.rpb = p.na_rpb + (size_t)(l * 4 + h) * 15 * 31;
        small_attn_item(p, it, OFF_DQ + 64 * h, OFF_DK + 64 * h, OFF_DV + 64 * h, 768 + 64 * h, 0.f, false, vs);
    }
}
DI void phase_attention(const Params& p, int l, int S, unsigned char* smem) {
#if (PH_MASK & 16384)
    {
        const int tid_ = otid(); const int wave = tid_ >> 6, lane = tid_ & 63;
        const bf16_t* qc = (const bf16_t*)(p.ws + WS_QC); const bf16_t* kvc = (const bf16_t*)(p.ws + WS_KVC); const bf16_t* kpe = (const bf16_t*)(p.ws + WS_KPE);
        bf16_t* ob = (bf16_t*)(p.ws + WS_H);
        for (int tok = blockIdx.x * 4 + wave; tok < TC; tok += gridDim.x * 4) {
            for (int c = lane; c < 256; c += 64) {
                const int h = c >> 6, d = c & 63;
                const float v = bf2f(qc[(size_t)tok * 384 + h * 96 + d]) + bf2f(qc[(size_t)tok * 384 + h * 96 + 32 + d]) + bf2f(kvc[(size_t)tok * 512 + h * 128 + d]) + bf2f(kvc[(size_t)tok * 512 + h * 128 + 64 + d]) + bf2f(kpe[(size_t)tok * 32 + (d & 31)]);
                ob[(size_t)tok * DM + 512 + c] = (bf16_t)(pk_bf16(v, 0.f) & 0xffffu);
            }
        }
        return;
    }
#endif
    constexpr int NC = 1024, NSMALL = 3 * 4 * 2048 / 4;
    for (int t = blockIdx.x; t < NC + NSMALL; t += gridDim.x) {
        if (t < NC) { if (PH_MASK & 2048) { const int item = (t & 7) * (NC / 8) + (t >> 3); attn_c_item(p, S, item, smem); } }
        else if (PH_MASK & 4096) { __syncthreads(); small_dispatch(p, l, S, (t - NC) * 4 + (otid() >> 6), smem); }
    }
    __syncthreads();
}

constexpr int SMEM_BYTES = 43008;
#ifndef MULTI_LAUNCH
#define MULTI_LAUNCH 0
#endif
DI void run_phase(const Params& p, int chunk, int l, int ph, unsigned char* smem) {
    bf16_t* Hb = (bf16_t*)(p.ws + WS_H); bf16_t* Ub = (bf16_t*)(p.ws + WS_U); bf16_t* proj = (bf16_t*)(p.ws + WS_PROJ);
    bf16_t* qcb = (bf16_t*)(p.ws + WS_QC); bf16_t* kvcb = (bf16_t*)(p.ws + WS_KVC);
    const int S = chunk ? 16384 : 2048;
    float* xo = p.x_out[chunk];
    const float* xsrc = (l == 0) ? p.x_in[chunk] : xo;
    switch (ph) {
    case 0: phase_prologue(p, smem); break;
    case 1: phase_rmsnorm_to_bf16(xsrc, p.norm_attn + l * DM, Hb, TC); break;
    case 2: { GemmArgs g{Hb, DM, (const bf16_t*)(p.ws + WS_WIN) + (size_t)l * PLD * DM, DM, DM}; phase_gemm(g, TC, PLD, EpiBf16{proj, PLD}, smem); } break;
    case 3: phase_mla_prep(p, l, S); break;
    case 4: {
        const GemmArgs gq{(const bf16_t*)(p.ws + WS_CQN), 256, (const bf16_t*)(p.ws + WS_WQUP) + (size_t)l * 384 * 256, 256, 256};
        const GemmArgs gk{(const bf16_t*)(p.ws + WS_CKVN), 128, (const bf16_t*)(p.ws + WS_WKVUP) + (size_t)l * 512 * 128, 128, 128};
        const int n_mt = TC >> 7;
#pragma unroll 1
        for (int t = blockIdx.x; t < n_mt * 7; t += gridDim.x) {
            int mt, nt; tile_map(t, n_mt, 7, mt, nt);
            if (nt < 3) gemm_tile(gq, mt << 7, nt << 7, EpiBf16{qcb, 384}, smem);
            else gemm_tile(gk, mt << 7, (nt - 3) << 7, EpiBf16{kvcb, 512}, smem);
        }
    } break;
    case 5: phase_attention(p, l, S, smem); break;
    case 6: phase_group_norm(Hb, p.group_norm + l * DM, TC); break;
    case 7: { GemmArgs g{Hb, DM, (const bf16_t*)(p.ws + WS_WOUT) + (size_t)l * DM * DM, DM, DM}; phase_gemm(g, TC, DM, EpiResid{xsrc, xo}, smem); } break;
    case 8: phase_rmsnorm_to_bf16(xo, p.norm_mlp + l * DM, Hb, TC); break;
    case 9: { GemmArgs g{Hb, DM, (const bf16_t*)(p.ws + WS_WUP) + (size_t)l * DFF * DM, DM, DM}; phase_gemm(g, TC, DFF, EpiRelu2{Ub, DFF}, smem); } break;
    case 10: { GemmArgs g{Ub, DFF, (const bf16_t*)(p.ws + WS_WDOWN) + (size_t)l * DM * DFF, DFF, DFF}; phase_gemm(g, TC, DM, EpiResid{xo, xo}, smem); } break;
    case 12: { GemmArgs g{Hb, DM, (const bf16_t*)(p.ws + WS_WIN) + (size_t)l * PLD * DM, DM, DM}; phase_gemm(g, TC, PLD, EpiBf16{(bf16_t*)(p.ws + WS_U + 100663296), PLD}, smem); } break;
    case 13: { GemmArgs g{Hb, DM, (const bf16_t*)(p.ws + WS_WIN), DM, DM}; phase_gemm(g, TC, PLD, EpiBf16{Ub, DFF}, smem); } break;
    case 14: { GemmArgs g{Hb, DM, (const bf16_t*)(p.ws + WS_WUP), DM, DM}; phase_gemm(g, TC, PLD, EpiBf16{proj, PLD}, smem); } break;
    default: phase_final_norm(p.x_out[chunk], p.norm_final, TC); break;
    }
}
#if MULTI_LAUNCH
__global__ void __launch_bounds__(256, 2) encoder_phase_kernel(Params p, int chunk, int l, int ph) {
    __shared__ __attribute__((aligned(16))) unsigned char smem[SMEM_BYTES];
    run_phase(p, chunk, l, ph, smem);
}
#else
__global__ void __launch_bounds__(256, 3) encoder_megakernel(Params p) {
    __shared__ __attribute__((aligned(16))) unsigned char smem[SMEM_BYTES];
    __shared__ uint4 xb_words;
    if (threadIdx.x == 0) xb_words = make_uint4(0u, 0u, 0u, 0u);
    __syncthreads();
    cg::this_grid().sync();
    XcdBarrier bar = xcd_barrier_post((unsigned*)(p.ws + WS_BAR), (volatile LAS unsigned*)&xb_words);
    run_phase(p, 0, 0, 0, smem);
    xcd_barrier(bar);
#pragma unroll 1
    for (int chunk = 0; chunk < 2; ++chunk) {
#pragma unroll 1
        for (int l = 0; l < DEPTH; ++l) {
#pragma unroll 1
            for (int ph = 1; ph <= 10; ++ph) { run_phase(p, chunk, l, ph, smem); xcd_barrier(bar); }
        }
        run_phase(p, chunk, 0, 11, smem);
    }
}
#endif


#ifndef DIAG
#define DIAG 0
#endif
#if DIAG
__global__ void diag_sum_kernel(const unsigned short* buf, size_t n, unsigned long long* slot  ) {
    unsigned long long s = 0, nf = 0;
    for (size_t i = (size_t)blockIdx.x * blockDim.x + threadIdx.x; i < n; i += (size_t)gridDim.x * blockDim.x) {
        const unsigned v = buf[i]; s += (unsigned long long)v * (unsigned long long)((i & 1023) + 1); nf += ((v & 0x7F80u) == 0x7F80u) ? 1u : 0u;
    }
    atomicAdd(slot, s); atomicAdd(slot + 1, nf);
}
__global__ void diag_mag_kernel(const unsigned short* buf, size_t n, unsigned long long* slot  ) {
    unsigned long long hg = 0, nn = 0, ni = 0;
    for (size_t i = (size_t)blockIdx.x * blockDim.x + threadIdx.x; i < n; i += (size_t)gridDim.x * blockDim.x) {
        const unsigned v = buf[i]; const unsigned e = (v >> 7) & 0xFFu, m = v & 0x7Fu;
        if (e == 0xFFu) { if (m) nn++; else ni++; } else if (e >= 147u) hg++;
    }
    atomicAdd(slot, hg); atomicAdd(slot + 1, nn); atomicAdd(slot + 2, ni);
}
__global__ void diag_zero_kernel(unsigned long long* slots, int n) { for (int i = threadIdx.x; i < n; i += blockDim.x) slots[i] = 0ull; }
__global__ void diag_report_kernel(float* out, size_t n, const unsigned long long* slots) {
    for (size_t i = (size_t)blockIdx.x * blockDim.x + threadIdx.x; i < n; i += (size_t)gridDim.x * blockDim.x) out[i] = 0.f;
    if (blockIdx.x == 0 && threadIdx.x == 0) {
        int bits = 0;
        if (slots[0]) bits |= 1;
        if (slots[4]) bits |= 2;
        if (slots[8]) bits |= 4;
        if (slots[13]) bits |= 8;
        if (slots[14]) bits |= 16;
        if (slots[13] + slots[14] > 1000ull) bits |= 32;
        out[0] = sqrtf((float)(10 + bits) * 33554432.0f * 1.0025f);
    }
}
#endif

extern "C" void kernel_launch(void* const* d_in, const int* in_sizes, int n_in, void* d_out, int out_size, void* d_ws, size_t ws_size, hipStream_t stream) {
    (void)in_sizes; (void)n_in; (void)out_size;
    if (ws_size < WS_END) { fprintf(stderr, "workspace too small: %zu < %zu\n", ws_size, (size_t)WS_END); return; }
    Params p{};
    p.x_in[0] = (const float*)d_in[0]; p.x_in[1] = (const float*)d_in[1];
    p.x_out[0] = (float*)d_out; p.x_out[1] = (float*)d_out + (size_t)TC * DM;
    p.norm_attn = (const float*)d_in[2]; p.w_in = (const float*)d_in[3]; p.mla_q_norm = (const float*)d_in[4]; p.w_q_up = (const float*)d_in[5];
    p.mla_kv_norm = (const float*)d_in[6]; p.w_kv_up = (const float*)d_in[7]; p.sink_logits = (const float*)d_in[8]; p.na_rpb = (const float*)d_in[9];
    p.group_norm = (const float*)d_in[10]; p.w_out = (const float*)d_in[11]; p.norm_mlp = (const float*)d_in[12]; p.w_mlp_up = (const float*)d_in[13];
    p.w_mlp_down = (const float*)d_in[14]; p.norm_final = (const float*)d_in[15];
    p.ws = (unsigned char*)d_ws;
#if MULTI_LAUNCH && DIAG
    {
        const int grid = 512;
        unsigned long long* slots = (unsigned long long*)((unsigned char*)d_ws + 8192);
        diag_zero_kernel<<<1, 64, 0, stream>>>(slots, 64);
        {
            unsigned char* w = (unsigned char*)d_ws;
            encoder_phase_kernel<<<grid, 256, 0, stream>>>(p, 0, 0, 0);
            encoder_phase_kernel<<<grid, 256, 0, stream>>>(p, 0, 0, 1);
            encoder_phase_kernel<<<grid, 256, 0, stream>>>(p, 0, 0, 2);
            diag_mag_kernel<<<1024, 256, 0, stream>>>((const unsigned short*)(w + WS_H), (size_t)TC * DM, slots + 0);
            diag_mag_kernel<<<1024, 256, 0, stream>>>((const unsigned short*)(w + WS_WIN), (size_t)PLD * DM, slots + 4);
            diag_mag_kernel<<<1024, 256, 0, stream>>>((const unsigned short*)(w + WS_WUP), (size_t)DFF * DM, slots + 8);
            diag_mag_kernel<<<1024, 256, 0, stream>>>((const unsigned short*)(w + WS_PROJ), (size_t)TC * PLD, slots + 12);
        }
        diag_report_kernel<<<1024, 256, 0, stream>>>((float*)d_out, (size_t)2 * TC * DM, slots);
        return;
    }
#endif
#if MULTI_LAUNCH
    const int grid = 512;
    encoder_phase_kernel<<<grid, 256, 0, stream>>>(p, 0, 0, 0);
    for (int chunk = 0; chunk < 2; ++chunk) {
        for (int l = 0; l < DEPTH; ++l)
            for (int ph = 1; ph <= 10; ++ph) encoder_phase_kernel<<<grid, 256, 0, stream>>>(p, chunk, l, ph);
        encoder_phase_kernel<<<grid, 256, 0, stream>>>(p, chunk, 0, 11);
    }
#else
    static int grid_blocks = 0;
    if (!grid_blocks) {
        int dev = 0, cus = 0, per_cu = 0;
        (void)hipGetDevice(&dev);
        (void)hipDeviceGetAttribute(&cus, hipDeviceAttributeMultiprocessorCount, dev);
        (void)hipOccupancyMaxActiveBlocksPerMultiprocessor(&per_cu, encoder_megakernel, 256, 0);
        if (per_cu > 3) per_cu = 3;
        if (per_cu < 1) per_cu = 1;
        grid_blocks = cus * per_cu;
    }
    (void)hipMemsetAsync(d_ws, 0, 16384, stream);
    void* args[] = {&p};
    hipError_t e = hipLaunchCooperativeKernel((void*)encoder_megakernel, dim3(grid_blocks), dim3(256), args, 0, stream);
    if (e != hipSuccess) fprintf(stderr, "cooperative launch failed: %s (grid %d)\n", hipGetErrorString(e), grid_blocks);
#endif
}
```

```cpp
#include <hip/hip_runtime.h>
#include <hip/hip_cooperative_groups.h>
#include <cstdint>
#include <cstdio>
namespace cg = cooperative_groups;

#define DI __device__ __forceinline__
#define LAS __attribute__((address_space(3)))

typedef unsigned short bf16_t;
typedef short bf16x8 __attribute__((ext_vector_type(8)));
typedef short s16x4 __attribute__((ext_vector_type(4)));
typedef float f32x4 __attribute__((ext_vector_type(4)));
typedef float f32x16 __attribute__((ext_vector_type(16)));
typedef unsigned u32x4 __attribute__((ext_vector_type(4)));
typedef unsigned u32x2 __attribute__((ext_vector_type(2)));

#ifndef TILE_GM
#define TILE_GM 4
#endif
#ifndef TRIVIAL_MAP
#define TRIVIAL_MAP 0
#endif
#ifndef PH_MASK
#define PH_MASK 0x1FFF
#endif
constexpr int DM = 1024, TC = 32768, DEPTH = 4, PLD = 2560, INW = 2464, DFF = 4096;
constexpr int OFF_AQ = 0, OFF_AK = 256, OFF_AV = 512, OFF_BQ = 768, OFF_BK = 1024, OFF_BV = 1152,
              OFF_CQ = 1280, OFF_CKV = 1536, OFF_CKR = 1664, OFF_DQ = 1696, OFF_DK = 1952, OFF_DV = 2208;
constexpr float EPS = 1e-5f;
constexpr float LOG2E = 1.4426950408889634f;

constexpr size_t WS_BAR = 0;
constexpr size_t WS_ROPE = 16384;
constexpr size_t WS_WIN = WS_ROPE + 2u * 16384u * 16u * 4u;
constexpr size_t SZ_WIN = (size_t)DEPTH * PLD * DM * 2;
constexpr size_t WS_WQUP = WS_WIN + SZ_WIN;
constexpr size_t SZ_WQUP = (size_t)DEPTH * 384 * 256 * 2;
constexpr size_t WS_WKVUP = WS_WQUP + SZ_WQUP;
constexpr size_t SZ_WKVUP = (size_t)DEPTH * 512 * 128 * 2;
constexpr size_t WS_WOUT = WS_WKVUP + SZ_WKVUP;
constexpr size_t SZ_WOUT = (size_t)DEPTH * DM * DM * 2;
constexpr size_t WS_WUP = WS_WOUT + SZ_WOUT;
constexpr size_t SZ_WUP = (size_t)DEPTH * DFF * DM * 2;
constexpr size_t WS_WDOWN = WS_WUP + SZ_WUP;
constexpr size_t SZ_WDOWN = (size_t)DEPTH * DM * DFF * 2;
constexpr size_t WS_H = WS_WDOWN + SZ_WDOWN;
constexpr size_t SZ_H = (size_t)TC * DM * 2;
constexpr size_t WS_U = WS_H + SZ_H;
constexpr size_t SZ_U = (size_t)TC * DFF * 2;
constexpr size_t WS_PROJ = WS_U;
constexpr size_t WS_QC = WS_PROJ + (size_t)TC * PLD * 2;
constexpr size_t WS_KVC = WS_QC + (size_t)TC * 384 * 2;
constexpr size_t WS_CQN = WS_U + SZ_U;
constexpr size_t WS_CKVN = WS_CQN + (size_t)TC * 256 * 2;
constexpr size_t WS_KPE = WS_CKVN + (size_t)TC * 128 * 2;
constexpr size_t WS_END = WS_KPE + (size_t)TC * 32 * 2;
static_assert(WS_KVC + (size_t)TC * 512 * 2 <= WS_END, "alias region");

struct Params {
    const float* x_in[2];
    float* x_out[2];
    const float *norm_attn, *w_in, *mla_q_norm, *w_q_up, *mla_kv_norm, *w_kv_up, *sink_logits, *na_rpb, *group_norm, *w_out,
        *norm_mlp, *w_mlp_up, *w_mlp_down, *norm_final;
    unsigned char* ws;
};

DI unsigned pk_bf16(float lo, float hi) { unsigned r; asm("v_cvt_pk_bf16_f32 %0, %1, %2" : "=v"(r) : "v"(lo), "v"(hi)); return r; }
DI float bf_lo(unsigned u) { return __uint_as_float(u << 16); }
DI float bf_hi(unsigned u) { return __uint_as_float(u & 0xffff0000u); }
DI float bf2f(bf16_t v) { return __uint_as_float(((unsigned)v) << 16); }
DI float wave_sum(float v) {
    v += __shfl_xor(v, 32); v += __shfl_xor(v, 16); v += __shfl_xor(v, 8); v += __shfl_xor(v, 4); v += __shfl_xor(v, 2); v += __shfl_xor(v, 1);
    return v;
}
DI float fexp2(float x) { return __builtin_amdgcn_exp2f(x); }
DI int otid() { int t = threadIdx.x; asm volatile("" : "+v"(t)); return t; }

#define XB_TMO      128
#define XB_XCNT(j)  (256  + 64 * (j))
#define XB_XSUB(j)  (1280 + 64 * (j))
#define XB_XGEN(j)  (2304 + 64 * (j))
#define XB_TOP      3328
#define XB_TOPGEN   3392
#define XCD_BAR_WORDS 3456
#define XB_SPIN_CAP (1u << 24)
DI unsigned xb_ld(unsigned* p) { return __hip_atomic_load(p, __ATOMIC_RELAXED, __HIP_MEMORY_SCOPE_AGENT); }
DI unsigned xb_add(unsigned* p, unsigned v) { return __hip_atomic_fetch_add(p, v, __ATOMIC_RELAXED, __HIP_MEMORY_SCOPE_AGENT); }
DI unsigned xb_xcc_id() { return (unsigned)__builtin_amdgcn_s_getreg((3 << 11) | 20) & 0xFu; }
#define XB_SPIN(cond, bar) do { unsigned _sp = 0; while (cond) { __builtin_amdgcn_s_sleep(1); \
    if ((++_sp & 255u) == 0u) { if (xb_ld(&(bar)[XB_TMO])) break; if (_sp > XB_SPIN_CAP) { atomicAdd(&(bar)[XB_TMO], 1u); break; } } } } while (0)
struct XcdBarrier { unsigned* bar; unsigned x; volatile LAS unsigned* st; };
DI XcdBarrier xcd_barrier_post(unsigned* bar, volatile LAS unsigned* st) {
    XcdBarrier b; b.bar = bar; b.x = xb_xcc_id(); b.st = st;
    if (threadIdx.x == 0) (void)xb_add(&bar[XB_XCNT(b.x)], 1u);
    return b;
}
DI void xcd_barrier_complete(unsigned* bar, unsigned x, unsigned& nloc, unsigned& nx) {
    const unsigned G = gridDim.x * gridDim.y * gridDim.z;
    unsigned sum, cnt, mine, sp = 0u;
    for (;;) {
        sum = 0u; cnt = 0u; mine = 0u;
#pragma unroll
        for (unsigned j = 0; j < 16; ++j) { const unsigned c = xb_ld(&bar[XB_XCNT(j)]); sum += c; cnt += (c > 0u) ? 1u : 0u; mine = (j == x) ? c : mine; }
        if (sum == G) break;
        __builtin_amdgcn_s_sleep(1);
        if ((++sp & 255u) == 0u) { if (xb_ld(&bar[XB_TMO])) break; if (sp > XB_SPIN_CAP) { atomicAdd(&bar[XB_TMO], 1u); break; } }
    }
    nloc = mine > 0u ? mine : 1u; nx = cnt > 0u ? cnt : 1u;
}
#ifndef USE_CG_SYNC
#define USE_CG_SYNC 0
#endif
DI void xcd_barrier(const XcdBarrier& b) {
#if USE_CG_SYNC
    (void)b; cg::this_grid().sync(); return;
#endif
    asm volatile("s_waitcnt vmcnt(0)" ::: "memory");
    __syncthreads();
    if (threadIdx.x == 0) {
        unsigned* bar = b.bar;
        __builtin_amdgcn_s_waitcnt(0);
        unsigned nloc = b.st[0], nx = b.st[1];
        if (nloc == 0u) { xcd_barrier_complete(bar, b.x, nloc, nx); b.st[0] = nloc; b.st[1] = nx; }
        const unsigned old = xb_add(&bar[XB_XSUB(b.x)], 1u);
        const unsigned gen = old / nloc;
        if (old + 1u == (gen + 1u) * nloc) {
            __builtin_amdgcn_fence(__ATOMIC_RELEASE, "agent");
            asm volatile("s_waitcnt vmcnt(0)" ::: "memory");
            const unsigned og = xb_add(&bar[XB_TOP], 1u);
            const unsigned tg = og / nx;
            if (og + 1u == (tg + 1u) * nx) xb_add(&bar[XB_TOPGEN], 1u);
            else XB_SPIN(xb_ld(&bar[XB_TOPGEN]) == tg, bar);
            __builtin_amdgcn_fence(__ATOMIC_ACQUIRE, "agent");
            xb_add(&bar[XB_XGEN(b.x)], 1u);
            asm volatile("s_waitcnt vmcnt(0)" ::: "memory");
        } else {
            XB_SPIN(xb_ld(&bar[XB_XGEN(b.x)]) == gen, bar);
            __builtin_amdgcn_fence(__ATOMIC_ACQUIRE, "agent");
            asm volatile("s_waitcnt vmcnt(0)" ::: "memory");
        }
    }
    __syncthreads();
}

DI void transpose_tile(const float* __restrict__ W, int K, int N, int Npad, bf16_t* __restrict__ Wt, int tile, float* tl) {
    const int ntn = Npad >> 6, kt = tile / ntn, nt = tile - kt * ntn, k0 = kt << 6, n0 = nt << 6;
    const int tid_ = otid(); const int tx = tid_ & 63, ty = tid_ >> 6;
#pragma unroll 4
    for (int r = 0; r < 16; ++r) { const int k = k0 + ty + 4 * r, n = n0 + tx; tl[(ty + 4 * r) * 65 + tx] = (n < N) ? W[(size_t)k * N + n] : 0.f; }
    __syncthreads();
#pragma unroll 4
    for (int r = 0; r < 16; ++r) { const int nl = ty + 4 * r; Wt[(size_t)(n0 + nl) * K + k0 + tx] = (bf16_t)(pk_bf16(tl[tx * 65 + nl], 0.f) & 0xffffu); }
    __syncthreads();
}
DI void phase_prologue(const Params& p, unsigned char* smem) {
    float* tl = (float*)smem;
    constexpr int PER_LAYER = 2984;
    for (int t = blockIdx.x; t < DEPTH * PER_LAYER; t += gridDim.x) {
        const int l = t / PER_LAYER; int r = t - l * PER_LAYER;
        if (r < 640) transpose_tile(p.w_in + (size_t)l * DM * INW, DM, INW, PLD, (bf16_t*)(p.ws + WS_WIN) + (size_t)l * PLD * DM, r, tl);
        else if (r < 664) transpose_tile(p.w_q_up + (size_t)l * 256 * 384, 256, 384, 384, (bf16_t*)(p.ws + WS_WQUP) + (size_t)l * 384 * 256, r - 640, tl);
        else if (r < 680) transpose_tile(p.w_kv_up + (size_t)l * 128 * 512, 128, 512, 512, (bf16_t*)(p.ws + WS_WKVUP) + (size_t)l * 512 * 128, r - 664, tl);
        else if (r < 936) transpose_tile(p.w_out + (size_t)l * DM * DM, DM, DM, DM, (bf16_t*)(p.ws + WS_WOUT) + (size_t)l * DM * DM, r - 680, tl);
        else if (r < 1960) transpose_tile(p.w_mlp_up + (size_t)l * DM * DFF, DM, DFF, DFF, (bf16_t*)(p.ws + WS_WUP) + (size_t)l * DFF * DM, r - 936, tl);
        else transpose_tile(p.w_mlp_down + (size_t)l * DFF * DM, DFF, DM, DM, (bf16_t*)(p.ws + WS_WDOWN) + (size_t)l * DM * DFF, r - 1960, tl);
    }
    float* rc = (float*)(p.ws + WS_ROPE); float* rs = rc + 16384 * 16;
    for (int idx = blockIdx.x * 256 + otid(); idx < 16384 * 16; idx += gridDim.x * 256) {
        const int pos = idx >> 4, i = idx & 15;
        const double invf = exp2(-(double)i * (13.287712379549449 / 16.0)) * 0.15915494309189535;
        const double rev = (double)pos * invf;
        const double fr = rev - floor(rev);
        const float ang = (float)(fr * 6.283185307179586);
        rc[idx] = cosf(ang); rs[idx] = sinf(ang);
    }
}

DI void phase_rmsnorm_to_bf16(const float* __restrict__ x, const float* __restrict__ g, bf16_t* __restrict__ out, int rows) {
    const int tid_ = otid(); const int wave = tid_ >> 6, lane = tid_ & 63;
    for (int row = blockIdx.x * 4 + wave; row < rows; row += gridDim.x * 4) {
        const float4* xr = (const float4*)(x + (size_t)row * DM);
        float4 v[4]; float ss = 0.f;
#pragma unroll
        for (int i = 0; i < 4; ++i) { v[i] = xr[lane + 64 * i]; ss += v[i].x * v[i].x + v[i].y * v[i].y + v[i].z * v[i].z + v[i].w * v[i].w; }
        ss = wave_sum(ss);
        const float rs = rsqrtf(ss * (1.0f / DM) + EPS);
#pragma unroll
        for (int i = 0; i < 4; ++i) {
            const float4 gg = ((const float4*)g)[lane + 64 * i];
            u32x2 o; o.x = pk_bf16(v[i].x * rs * gg.x, v[i].y * rs * gg.y); o.y = pk_bf16(v[i].z * rs * gg.z, v[i].w * rs * gg.w);
            *(u32x2*)(out + (size_t)row * DM + 4 * (lane + 64 * i)) = o;
        }
    }
}
DI void phase_final_norm(float* __restrict__ x, const float* __restrict__ g, int rows) {
    const int tid_ = otid(); const int wave = tid_ >> 6, lane = tid_ & 63;
    for (int row = blockIdx.x * 4 + wave; row < rows; row += gridDim.x * 4) {
        float4* xr = (float4*)(x + (size_t)row * DM);
        float4 v[4]; float ss = 0.f;
#pragma unroll
        for (int i = 0; i < 4; ++i) { v[i] = xr[lane + 64 * i]; ss += v[i].x * v[i].x + v[i].y * v[i].y + v[i].z * v[i].z + v[i].w * v[i].w; }
        ss = wave_sum(ss);
        const float rs = rsqrtf(ss * (1.0f / DM) + EPS);
#pragma unroll
        for (int i = 0; i < 4; ++i) {
            const float4 gg = ((const float4*)g)[lane + 64 * i];
            float4 o; o.x = v[i].x * rs * gg.x; o.y = v[i].y * rs * gg.y; o.z = v[i].z * rs * gg.z; o.w = v[i].w * rs * gg.w;
            __builtin_nontemporal_store(o.x, &xr[lane + 64 * i].x); __builtin_nontemporal_store(o.y, &xr[lane + 64 * i].y); __builtin_nontemporal_store(o.z, &xr[lane + 64 * i].z); __builtin_nontemporal_store(o.w, &xr[lane + 64 * i].w);
        }
    }
}
DI void phase_group_norm(bf16_t* __restrict__ o, const float* __restrict__ g, int rows) {
    const int tid_ = otid(); const int wave = tid_ >> 6, lane = tid_ & 63;
    for (int row = blockIdx.x * 4 + wave; row < rows; row += gridDim.x * 4) {
        u32x4* pr = (u32x4*)(o + (size_t)row * DM) + 2 * lane;
        const u32x4 a = pr[0], b = pr[1];
        float f[16];
#pragma unroll
        for (int j = 0; j < 4; ++j) { f[2 * j] = bf_lo(a[j]); f[2 * j + 1] = bf_hi(a[j]); f[8 + 2 * j] = bf_lo(b[j]); f[8 + 2 * j + 1] = bf_hi(b[j]); }
        float ss = 0.f;
#pragma unroll
        for (int j = 0; j < 16; ++j) ss += f[j] * f[j];
        ss += __shfl_xor(ss, 8); ss += __shfl_xor(ss, 4); ss += __shfl_xor(ss, 2); ss += __shfl_xor(ss, 1);
        const float rs = rsqrtf(ss * (1.0f / 256.0f) + EPS);
        const float4* gp = (const float4*)(g + 16 * lane);
        u32x4 oa, ob;
#pragma unroll
        for (int j = 0; j < 2; ++j) {
            const float4 g0 = gp[j];
            oa[2 * j] = pk_bf16(f[4 * j] * rs * g0.x, f[4 * j + 1] * rs * g0.y); oa[2 * j + 1] = pk_bf16(f[4 * j + 2] * rs * g0.z, f[4 * j + 3] * rs * g0.w);
            const float4 g1 = gp[2 + j];
            ob[2 * j] = pk_bf16(f[8 + 4 * j] * rs * g1.x, f[8 + 4 * j + 1] * rs * g1.y); ob[2 * j + 1] = pk_bf16(f[8 + 4 * j + 2] * rs * g1.z, f[8 + 4 * j + 3] * rs * g1.w);
        }
        pr[0] = oa; pr[1] = ob;
    }
}
DI void phase_mla_prep(const Params& p, int l, int S) {
    const int tid_ = otid(); const int wave = tid_ >> 6, lane = tid_ & 63;
    bf16_t* proj = (bf16_t*)(p.ws + WS_PROJ);
    const float* qn = p.mla_q_norm + l * 256; const float* kn = p.mla_kv_norm + l * 128;
    const float* rc = (const float*)(p.ws + WS_ROPE); const float* rsn = rc + 16384 * 16;
    for (int tok = blockIdx.x * 4 + wave; tok < TC; tok += gridDim.x * 4) {
        bf16_t* row = proj + (size_t)tok * PLD;
        const int pos = tok & (S - 1);
        const u32x2 cq = *(const u32x2*)(row + OFF_CQ + 4 * lane);
        const unsigned ckv = *(const unsigned*)(row + OFF_CKV + 2 * lane);
        float x1 = 0.f, x2 = 0.f;
        if (lane < 16) { x1 = bf2f(row[OFF_CKR + lane]); x2 = bf2f(row[OFF_CKR + 16 + lane]); }
        const float q0 = bf_lo(cq.x), q1 = bf_hi(cq.x), q2 = bf_lo(cq.y), q3 = bf_hi(cq.y);
        const float k0 = bf_lo(ckv), k1 = bf_hi(ckv);
        const float sq = wave_sum(q0 * q0 + q1 * q1 + q2 * q2 + q3 * q3);
        const float sk = wave_sum(k0 * k0 + k1 * k1);
        const float rq = rsqrtf(sq * (1.0f / 256.0f) + EPS), rk = rsqrtf(sk * (1.0f / 128.0f) + EPS);
        const float4 gq = *(const float4*)(qn + 4 * lane); const float2 gk = *(const float2*)(kn + 2 * lane);
        u32x2 oq; oq.x = pk_bf16(q0 * rq * gq.x, q1 * rq * gq.y); oq.y = pk_bf16(q2 * rq * gq.z, q3 * rq * gq.w);
        *(u32x2*)((bf16_t*)(p.ws + WS_CQN) + (size_t)tok * 256 + 4 * lane) = oq;
        *(unsigned*)((bf16_t*)(p.ws + WS_CKVN) + (size_t)tok * 128 + 2 * lane) = pk_bf16(k0 * rk * gk.x, k1 * rk * gk.y);
        if (lane < 16) {
            const float c = rc[pos * 16 + lane], s = rsn[pos * 16 + lane];
            const unsigned o = pk_bf16(x1 * c - x2 * s, x1 * s + x2 * c);
            bf16_t* kp = (bf16_t*)(p.ws + WS_KPE) + (size_t)tok * 32;
            kp[lane] = (bf16_t)(o & 0xffffu); kp[16 + lane] = (bf16_t)(o >> 16);
        }
    }
}

constexpr int G_BK = 64;
constexpr int G_LDS_ROW = 64;
constexpr int G_TILE_ELEMS = 128 * G_LDS_ROW;
struct GemmArgs { const bf16_t* A; int lda; const bf16_t* Bt; int ldb; int K; };

struct EpiBf16 { bf16_t* C; int ldc;
    DI void operator()(int m, int n, const f32x16& v) const {
        u32x4 o0, o1;
#pragma unroll
        for (int j = 0; j < 4; ++j) { o0[j] = pk_bf16(v[2 * j], v[2 * j + 1]); o1[j] = pk_bf16(v[8 + 2 * j], v[8 + 2 * j + 1]); }
        u32x4* d = (u32x4*)(C + (size_t)m * ldc + n); d[0] = o0; d[1] = o1; } };
struct EpiRelu2 { bf16_t* C; int ldc;
    DI void operator()(int m, int n, const f32x16& v) const {
        float t[16];
#pragma unroll
        for (int e = 0; e < 16; ++e) { const float a = fmaxf(v[e], 0.f); t[e] = a * a; }
        u32x4 o0, o1;
#pragma unroll
        for (int j = 0; j < 4; ++j) { o0[j] = pk_bf16(t[2 * j], t[2 * j + 1]); o1[j] = pk_bf16(t[8 + 2 * j], t[8 + 2 * j + 1]); }
        u32x4* d = (u32x4*)(C + (size_t)m * ldc + n); d[0] = o0; d[1] = o1; } };
struct EpiResid { const float* xin; float* xout;
    DI void operator()(int m, int n, const f32x16& v) const {
        const float4* s = (const float4*)(xin + (size_t)m * DM + n); float4* d = (float4*)(xout + (size_t)m * DM + n);
#pragma unroll
        for (int q = 0; q < 4; ++q) { const float4 r = s[q]; float4 o; o.x = r.x + v[4 * q]; o.y = r.y + v[4 * q + 1]; o.z = r.z + v[4 * q + 2]; o.w = r.w + v[4 * q + 3]; d[q] = o; } } };

template <class Epi>
DI void gemm_tile(const GemmArgs& g, int m0, int n0, const Epi& epi, unsigned char* smem) {
    bf16_t* As = (bf16_t*)smem; bf16_t* Bs = As + G_TILE_ELEMS;
    const int tid = otid(), lane = tid & 63, wave = tid >> 6, wm = wave >> 1, wn = wave & 1, r = lane & 31, hh = lane >> 5;
    const int lrow = tid >> 3, lch = tid & 7;
    const bf16_t* ga = g.A + (size_t)(m0 + lrow) * g.lda + lch * 8;
    const bf16_t* gb = g.Bt + (size_t)(n0 + lrow) * g.ldb + lch * 8;
    const size_t sa = (size_t)32 * g.lda, sb = (size_t)32 * g.ldb;
    int wofs[4];
#pragma unroll
    for (int i = 0; i < 4; ++i) { const int row = lrow + 32 * i; wofs[i] = row * G_LDS_ROW + ((lch ^ ((row >> 1) & 7)) << 3); }
    f32x16 acc[2][2];
#pragma unroll
    for (int i = 0; i < 2; ++i)
#pragma unroll
        for (int j = 0; j < 2; ++j)
#pragma unroll
            for (int e = 0; e < 16; ++e) acc[i][j][e] = 0.f;
    u32x4 ra[4], rb[4];
    const int KT = g.K / G_BK;
    const int rsw = (r >> 1) & 7;
    const int nperm = 16 * ((r >> 2) & 1) + 4 * (r >> 3) + (r & 3), rswb = (nperm >> 1) & 7;
    const bf16_t* Abase = As + (64 * wm + r) * G_LDS_ROW;
    const bf16_t* Bbase = Bs + (64 * wn + nperm) * G_LDS_ROW;
    __syncthreads();
#pragma unroll
    for (int i = 0; i < 4; ++i) { ra[i] = *(const u32x4*)(ga + i * sa); rb[i] = *(const u32x4*)(gb + i * sb); }
#pragma unroll
    for (int i = 0; i < 4; ++i) { *(u32x4*)(As + wofs[i]) = ra[i]; *(u32x4*)(Bs + wofs[i]) = rb[i]; }
    __syncthreads();
#pragma unroll 1
    for (int kt = 0; kt < KT; ++kt) {
        if (kt + 1 < KT) {
            const int k0 = (kt + 1) * G_BK;
#pragma unroll
            for (int i = 0; i < 4; ++i) { ra[i] = *(const u32x4*)(ga + i * sa + k0); rb[i] = *(const u32x4*)(gb + i * sb + k0); }
        }
        __builtin_amdgcn_s_setprio(1);
#pragma unroll
        for (int kk = 0; kk < G_BK / 16; ++kk) {
            const int pc = ((2 * kk + hh) ^ rsw) << 3, pcb = ((2 * kk + hh) ^ rswb) << 3;
            bf16x8 af[2], bfr[2];
#pragma unroll
            for (int i = 0; i < 2; ++i) { af[i] = *(const bf16x8*)(Abase + 32 * i * G_LDS_ROW + pc); bfr[i] = *(const bf16x8*)(Bbase + 32 * i * G_LDS_ROW + pcb); }
#pragma unroll
            for (int i = 0; i < 2; ++i)
#pragma unroll
                for (int j = 0; j < 2; ++j) acc[i][j] = __builtin_amdgcn_mfma_f32_32x32x16_bf16(bfr[j], af[i], acc[i][j], 0, 0, 0);
        }
        __builtin_amdgcn_s_setprio(0);
        __syncthreads();
        if (kt + 1 < KT) {
#pragma unroll
            for (int i = 0; i < 4; ++i) { *(u32x4*)(As + wofs[i]) = ra[i]; *(u32x4*)(Bs + wofs[i]) = rb[i]; }
        }
        __syncthreads();
    }
#pragma unroll
    for (int i = 0; i < 2; ++i)
#pragma unroll
        for (int j = 0; j < 2; ++j)
            epi(m0 + 64 * wm + 32 * i + r, n0 + 64 * wn + 32 * j + 16 * hh, acc[i][j]);
}
DI void tile_map(int t, int n_mt, int n_nt, int& mt, int& nt) {
#if TRIVIAL_MAP
    (void)n_mt; mt = t / n_nt; nt = t - mt * n_nt;
#else
    const int x = t & 7, j = t >> 3, mpx = n_mt >> 3, gsz = TILE_GM * n_nt;
    const int gi = j / gsz, rem = j - gi * gsz;
    mt = x * mpx + gi * TILE_GM + (rem % TILE_GM); nt = rem / TILE_GM;
#endif
}
template <class Epi>
DI void phase_gemm(const GemmArgs& g, int M, int N, const Epi& epi, unsigned char* smem) {
    const int n_mt = M >> 7, n_nt = N >> 7, total = n_mt * n_nt;
    for (int t = blockIdx.x; t < total; t += gridDim.x) { int mt, nt; tile_map(t, n_mt, n_nt, mt, nt); gemm_tile(g, mt << 7, nt << 7, epi, smem); }
}

constexpr int C_KROW = 104;
constexpr int C_KBYTES = 64 * C_KROW * 2;
constexpr int C_VBYTES = 2 * 64 * 64;
constexpr int C_BUF = C_KBYTES + C_VBYTES;
DI void attn_c_item(const Params& p, int S, int item, unsigned char* smem) {
#if (PH_MASK & 8192)
    {
        const int tid = otid(); const int nqt = S >> 7;
        const int qt = item % nqt; const int h = (item / nqt) & 3; const int seq = item / (nqt * 4);
        const bf16_t* proj = (const bf16_t*)(p.ws + WS_PROJ); const bf16_t* qc = (const bf16_t*)(p.ws + WS_QC); const bf16_t* kvc = (const bf16_t*)(p.ws + WS_KVC);
        bf16_t* ob = (bf16_t*)(p.ws + WS_H);
        for (int e = tid; e < 128 * 64; e += 256) {
            const int tok = seq * S + qt * 128 + (e >> 6), d = e & 63;
            const float v = bf2f(qc[(size_t)tok * 384 + h * 96 + d]) + bf2f(qc[(size_t)tok * 384 + h * 96 + 32 + d]) + bf2f(kvc[(size_t)tok * 512 + h * 128 + d]) + bf2f(kvc[(size_t)tok * 512 + h * 128 + 64 + d]) + bf2f(((const bf16_t*)(p.ws + WS_KPE))[(size_t)tok * 32 + (d & 31)]);
            ob[(size_t)tok * DM + 512 + h * 64 + d] = (bf16_t)(pk_bf16(v, 0.f) & 0xffffu);
        }
        return;
    }
#endif
    const int tid = otid(), lane = tid & 63, wave = tid >> 6, r = lane & 31, hh = lane >> 5;
    const int nqt = S >> 7;
    const int qt = item % nqt; const int h = (item / nqt) & 3; const int seq = item / (nqt * 4);
    const int seqbase = seq * S;
    const bf16_t* proj = (const bf16_t*)(p.ws + WS_PROJ);
    const bf16_t* qc = (const bf16_t*)(p.ws + WS_QC);
    const bf16_t* kvc = (const bf16_t*)(p.ws + WS_KVC);
    bf16_t* ob = (bf16_t*)(p.ws + WS_H);
    const float* rc = (const float*)(p.ws + WS_ROPE); const float* rsn = rc + 16384 * 16;
    constexpr float QSC = 0.10206207261596577f * LOG2E;
    const int qpos = qt * 128 + wave * 32 + r; const int qtok = seqbase + qpos;
    bf16x8 qf[6];
    {
        const bf16_t* qrow = qc + (size_t)qtok * 384 + h * 96;
#pragma unroll
        for (int kk = 0; kk < 4; ++kk) {
            const u32x4 qv = *(const u32x4*)(qrow + 16 * kk + 8 * hh); u32x4 qs;
#pragma unroll
            for (int j = 0; j < 4; ++j) qs[j] = pk_bf16(bf_lo(qv[j]) * QSC, bf_hi(qv[j]) * QSC);
            qf[kk] = __builtin_bit_cast(bf16x8, qs);
        }
        const u32x4 x1 = *(const u32x4*)(qrow + 64 + 8 * hh), x2 = *(const u32x4*)(qrow + 80 + 8 * hh);
        const float4 c0 = *(const float4*)(rc + qpos * 16 + 8 * hh), c1 = *(const float4*)(rc + qpos * 16 + 8 * hh + 4);
        const float4 s0 = *(const float4*)(rsn + qpos * 16 + 8 * hh), s1 = *(const float4*)(rsn + qpos * 16 + 8 * hh + 4);
        const float cs[8] = {c0.x, c0.y, c0.z, c0.w, c1.x, c1.y, c1.z, c1.w};
        const float sn[8] = {s0.x, s0.y, s0.z, s0.w, s1.x, s1.y, s1.z, s1.w};
        u32x4 o1, o2;
#pragma unroll
        for (int j = 0; j < 4; ++j) {
            const float a0 = bf_lo(x1[j]), a1 = bf_hi(x1[j]), b0 = bf_lo(x2[j]), b1 = bf_hi(x2[j]);
            o1[j] = pk_bf16((a0 * cs[2 * j] - b0 * sn[2 * j]) * QSC, (a1 * cs[2 * j + 1] - b1 * sn[2 * j + 1]) * QSC);
            o2[j] = pk_bf16((a0 * sn[2 * j] + b0 * cs[2 * j]) * QSC, (a1 * sn[2 * j + 1] + b1 * cs[2 * j + 1]) * QSC);
        }
        qf[4] = __builtin_bit_cast(bf16x8, o1); qf[5] = __builtin_bit_cast(bf16x8, o2);
    }
    const int lkey = tid >> 3, lch = tid & 7;
    const int pkey = tid >> 2, pch = tid & 3;
    const bf16_t* gkv = kvc + (size_t)(seqbase + lkey) * 512 + h * 128 + 8 * lch;
    const bf16_t* gpe = (const bf16_t*)(p.ws + WS_KPE) + (size_t)(seqbase + pkey) * 32 + 8 * pch;
    const int dk0 = lkey * (C_KROW * 2) + lch * 16;
    const int dv0 = C_KBYTES + (lch >> 2) * 4096 + lkey * 64 + (lch & 3) * 16;
    const int dp0 = pkey * (C_KROW * 2) + 128 + pch * 16;
    u32x4 rg[5];
    const int nkt = S >> 6;
    const float cscale = 0.10206207261596577f * LOG2E;
    float m_run = 0.f, l_run = 0.f;
    f32x16 o[2];
#pragma unroll
    for (int e = 0; e < 16; ++e) { o[0][e] = 0.f; o[1][e] = 0.f; }
    __syncthreads();
#define C_LOAD(kt_) do { const size_t ko = (size_t)(kt_) * 64; \
        rg[0] = *(const u32x4*)(gkv + ko * 512); rg[1] = *(const u32x4*)(gkv + (ko + 32) * 512); \
        rg[2] = *(const u32x4*)(gkv + ko * 512 + 64); rg[3] = *(const u32x4*)(gkv + (ko + 32) * 512 + 64); \
        rg[4] = *(const u32x4*)(gpe + ko * 32); } while (0)
#define C_STORE(b_) do { unsigned char* bb = smem + (b_) * C_BUF; \
        *(u32x4*)(bb + dk0) = rg[0]; *(u32x4*)(bb + dk0 + 32 * C_KROW * 2) = rg[1]; \
        *(u32x4*)(bb + dv0) = rg[2]; *(u32x4*)(bb + dv0 + 32 * 64) = rg[3]; \
        *(u32x4*)(bb + dp0) = rg[4]; } while (0)
    C_LOAD(0); C_STORE(0);
    __syncthreads();
    const int sg = lane >> 4, li = lane & 15;
    const int vrd = ((sg >> 1) * 4 + (li >> 2)) * 64 + ((sg & 1) * 16 + (li & 3) * 4) * 2;
#pragma unroll 1
    for (int kt = 0; kt < nkt; ++kt) {
        const int buf = kt & 1;
        if (kt + 1 < nkt) C_LOAD(kt + 1);
        const unsigned char* kb = smem + buf * C_BUF;
        const unsigned char* vb = kb + C_KBYTES;
        f32x16 s[2];
#pragma unroll
        for (int st = 0; st < 2; ++st) {
#pragma unroll
            for (int e = 0; e < 16; ++e) s[st][e] = -m_run;
#pragma unroll
            for (int kk = 0; kk < 6; ++kk) {
                const bf16x8 kf = *(const bf16x8*)(kb + (32 * st + r) * (C_KROW * 2) + (16 * kk + 8 * hh) * 2);
                s[st] = __builtin_amdgcn_mfma_f32_32x32x16_bf16(kf, qf[kk], s[st], 0, 0, 0);
            }
        }
        float mx = fmaxf(s[0][0], s[1][0]);
#pragma unroll
        for (int e = 1; e < 16; ++e) mx = fmaxf(mx, fmaxf(s[0][e], s[1][e]));
        { const auto sw = __builtin_amdgcn_permlane32_swap(__float_as_uint(mx), __float_as_uint(mx), false, false); mx = fmaxf(__uint_as_float(sw[0]), __uint_as_float(sw[1])); }
        if (__any(mx > 0.f)) {
            const float up = fmaxf(mx, 0.f), alpha = fexp2(-up);
#pragma unroll
            for (int e = 0; e < 16; ++e) { o[0][e] *= alpha; o[1][e] *= alpha; s[0][e] -= up; s[1][e] -= up; }
            l_run *= alpha; m_run += up;
        }
#pragma unroll
        for (int st = 0; st < 2; ++st) {
            float pe[16]; float ls = 0.f;
#pragma unroll
            for (int e = 0; e < 16; ++e) { pe[e] = fexp2(s[st][e]); ls += pe[e]; }
            l_run += ls;
            u32x4 p0, p1;
#pragma unroll
            for (int j = 0; j < 4; ++j) { p0[j] = pk_bf16(pe[2 * j], pe[2 * j + 1]); p1[j] = pk_bf16(pe[8 + 2 * j], pe[8 + 2 * j + 1]); }
            const bf16x8 pf0 = __builtin_bit_cast(bf16x8, p0), pf1 = __builtin_bit_cast(bf16x8, p1);
#pragma unroll
            for (int db = 0; db < 2; ++db) {
#pragma unroll
                for (int s2 = 0; s2 < 2; ++s2) {
                    const unsigned char* va = vb + db * 4096 + (32 * st + 16 * s2) * 64 + vrd;
                    const s16x4 t0 = __builtin_amdgcn_ds_read_tr16_b64_v4i16((LAS s16x4*)(va));
                    const s16x4 t1 = __builtin_amdgcn_ds_read_tr16_b64_v4i16((LAS s16x4*)(va + 8 * 64));
                    const bf16x8 vf = {t0[0], t0[1], t0[2], t0[3], t1[0], t1[1], t1[2], t1[3]};
                    o[db] = __builtin_amdgcn_mfma_f32_32x32x16_bf16(vf, s2 ? pf1 : pf0, o[db], 0, 0, 0);
                }
            }
        }
        if (kt + 1 < nkt) C_STORE(buf ^ 1);
        __syncthreads();
    }
#undef C_LOAD
#undef C_STORE
    const float lt = l_run + __shfl_xor(l_run, 32);
    const float inv = 1.0f / lt;
    bf16_t* orow = ob + (size_t)qtok * DM + 512 + h * 64;
#pragma unroll
    for (int db = 0; db < 2; ++db)
#pragma unroll
        for (int q4 = 0; q4 < 4; ++q4) {
            u32x2 w; w.x = pk_bf16(o[db][4 * q4] * inv, o[db][4 * q4 + 1] * inv); w.y = pk_bf16(o[db][4 * q4 + 2] * inv, o[db][4 * q4 + 3] * inv);
            *(u32x2*)(orow + 32 * db + 8 * q4 + 4 * hh) = w;
        }
}

constexpr int SM_VROW = 72;
struct SmallItem {
    int mode;
    int S, seqbase, h;
    int q0, qstride;
    int ntiles;
    int rowstart, cs, r;
    float slope2;
    const float* rpb;
};
DI int small_keypos(const SmallItem& it, int t, int kidx) {
    if (it.mode == 0) {
        if (t < 12) return it.q0 - 64 + 32 * t + kidx;
        if (t < 18) return it.q0 - 256 + 4 * (32 * (t - 12) + kidx);
        return it.q0 - 1024 + 16 * (32 * (t - 18) + kidx);
    } else if (it.mode == 1) {
        return it.q0 - 128 + 32 * t + kidx;
    } else {
        return (it.rowstart + t) * 64 + it.cs + kidx;
    }
}
DI float small_bias(const SmallItem& it, int t, int kp, int qp) {
    const float NINF = -__builtin_inff();
    if (it.mode == 0) {
        const int W = t < 12 ? 64 : (t < 18 ? 256 : 1024);
        const int d = kp > qp ? kp - qp : qp - kp;
        return (kp >= 0 && kp < it.S && d <= W) ? -it.slope2 * (float)d : NINF;
    } else if (it.mode == 1) {
        const int d = kp > qp ? kp - qp : qp - kp;
        return (kp >= 0 && kp < it.S && d <= 128) ? -it.slope2 * (float)d : NINF;
    } else {
        const int kc = kp & 63, qc = qp & 63;
        int cst = qc - 8; cst = cst < 0 ? 0 : (cst > 48 ? 48 : cst);
        int dc = kc - qc; dc = dc < -15 ? -15 : (dc > 15 ? 15 : dc);
        const int dr = it.rowstart + t - it.r + 7;
        const float b = it.rpb[dr * 31 + dc + 15] * LOG2E;
        return (kc >= cst && kc < cst + 16) ? b : NINF;
    }
}
DI void small_attn_item(const Params& p, const SmallItem& it, int qoff, int koff, int voff, int ooff, float sink2, bool has_sink, bf16_t* vs  ) {
    const int lane = otid() & 63, li = lane & 15, g = lane >> 4;
    const bf16_t* proj = (const bf16_t*)(p.ws + WS_PROJ);
    bf16_t* ob = (bf16_t*)(p.ws + WS_H);
    const int qp = it.q0 + li * it.qstride;
    const int qtok = it.seqbase + qp;
    bf16x8 qf[2];
    qf[0] = *(const bf16x8*)(proj + (size_t)qtok * PLD + qoff + 8 * g);
    qf[1] = *(const bf16x8*)(proj + (size_t)qtok * PLD + qoff + 32 + 8 * g);
    const int key_a = 8 * (li >> 2) + (li & 3);
    float m_run = has_sink ? sink2 : -__builtin_inff();
    float l_run = (has_sink && g == 0) ? 1.0f : 0.f;
    f32x4 o[4];
#pragma unroll
    for (int db = 0; db < 4; ++db) o[db] = (f32x4){0.f, 0.f, 0.f, 0.f};
    const float sc2 = 0.125f * LOG2E;
    const float NINF = -__builtin_inff();
    int dci[8]; bool dva[8];
    {
        const int qc = qp & 63; int cst = qc - 8; cst = cst < 0 ? 0 : (cst > 48 ? 48 : cst);
#pragma unroll
        for (int e = 0; e < 8; ++e) { const int kc = it.cs + 8 * g + e; int dc = kc - qc; dc = dc < -15 ? -15 : (dc > 15 ? 15 : dc); dci[e] = dc + 15; dva[e] = (kc >= cst) && (kc < cst + 16); }
    }
    for (int t = 0; t < it.ntiles; t += 2) {
        bf16x8 kf[2][4]; u32x4 vr[2][4];
#pragma unroll
        for (int u = 0; u < 2; ++u) {
            const int tt = t + u; int tbase, tstride;
            if (it.mode == 0) { if (tt < 12) { tbase = it.q0 - 64 + 32 * tt; tstride = 1; } else if (tt < 18) { tbase = it.q0 - 256 + 128 * (tt - 12); tstride = 4; } else { tbase = it.q0 - 1024 + 512 * (tt - 18); tstride = 16; } }
            else if (it.mode == 1) { tbase = it.q0 - 128 + 32 * tt; tstride = 1; }
            else { tbase = (it.rowstart + tt) * 64 + it.cs; tstride = 1; }
            int ka = tbase + tstride * key_a, kb = tbase + tstride * (key_a + 4);
            ka = ka < 0 ? 0 : (ka > it.S - 1 ? it.S - 1 : ka); kb = kb < 0 ? 0 : (kb > it.S - 1 ? it.S - 1 : kb);
            const bf16_t* kra = proj + (size_t)(it.seqbase + ka) * PLD + koff + 8 * g;
            const bf16_t* krb = proj + (size_t)(it.seqbase + kb) * PLD + koff + 8 * g;
            kf[u][0] = *(const bf16x8*)(kra); kf[u][1] = *(const bf16x8*)(kra + 32); kf[u][2] = *(const bf16x8*)(krb); kf[u][3] = *(const bf16x8*)(krb + 32);
#pragma unroll
            for (int n = 0; n < 4; ++n) {
                const int c = lane + 64 * n, key = c >> 3, dch = c & 7;
                int kp = tbase + tstride * key; kp = kp < 0 ? 0 : (kp > it.S - 1 ? it.S - 1 : kp);
                vr[u][n] = *(const u32x4*)(proj + (size_t)(it.seqbase + kp) * PLD + voff + 8 * dch);
            }
        }
        asm volatile("s_waitcnt lgkmcnt(0)" ::: "memory");
#pragma unroll
        for (int u = 0; u < 2; ++u)
#pragma unroll
            for (int n = 0; n < 4; ++n) { const int c = lane + 64 * n, key = c >> 3, dch = c & 7; *(u32x4*)(vs + (32 * u + key) * SM_VROW + 8 * dch) = vr[u][n]; }
        float sv[16];
#pragma unroll
        for (int u = 0; u < 2; ++u) {
            f32x4 sa = (f32x4){0.f, 0.f, 0.f, 0.f}, sb = (f32x4){0.f, 0.f, 0.f, 0.f};
            sa = __builtin_amdgcn_mfma_f32_16x16x32_bf16(kf[u][0], qf[0], sa, 0, 0, 0); sa = __builtin_amdgcn_mfma_f32_16x16x32_bf16(kf[u][1], qf[1], sa, 0, 0, 0);
            sb = __builtin_amdgcn_mfma_f32_16x16x32_bf16(kf[u][2], qf[0], sb, 0, 0, 0); sb = __builtin_amdgcn_mfma_f32_16x16x32_bf16(kf[u][3], qf[1], sb, 0, 0, 0);
            const int tt = t + u;
            if (it.mode != 2) {
                int tbase, tstride, tw;
                if (it.mode == 0) { if (tt < 12) { tbase = it.q0 - 64 + 32 * tt; tstride = 1; tw = 64; } else if (tt < 18) { tbase = it.q0 - 256 + 128 * (tt - 12); tstride = 4; tw = 256; } else { tbase = it.q0 - 1024 + 512 * (tt - 18); tstride = 16; tw = 1024; } }
                else { tbase = it.q0 - 128 + 32 * tt; tstride = 1; tw = 128; }
#pragma unroll
                for (int e = 0; e < 8; ++e) {
                    const int kp = tbase + tstride * (8 * g + e); const int dd = kp > qp ? kp - qp : qp - kp;
                    const float bias = ((unsigned)kp < (unsigned)it.S && dd <= tw) ? -it.slope2 * (float)dd : NINF;
                    sv[8 * u + e] = (e < 4 ? sa[e] : sb[e - 4]) * sc2 + bias;
                }
            } else {
                const float* rowp = it.rpb + (it.rowstart + tt - it.r + 7) * 31;
#pragma unroll
                for (int e = 0; e < 8; ++e) sv[8 * u + e] = (e < 4 ? sa[e] : sb[e - 4]) * sc2 + (dva[e] ? rowp[dci[e]] * LOG2E : NINF);
            }
        }
        float mx = sv[0];
#pragma unroll
        for (int e = 1; e < 16; ++e) mx = fmaxf(mx, sv[e]);
        mx = fmaxf(mx, __shfl_xor(mx, 16)); mx = fmaxf(mx, __shfl_xor(mx, 32));
        const float m_new = fmaxf(m_run, mx);
        const float m_use = (m_new == -__builtin_inff()) ? 0.f : m_new;
        const float alpha = fexp2(m_run - m_use);
        float pe[16]; float ls = 0.f;
#pragma unroll
        for (int e = 0; e < 16; ++e) { pe[e] = fexp2(sv[e] - m_use); ls += pe[e]; }
        l_run = l_run * alpha + ls; m_run = m_new;
#pragma unroll
        for (int db = 0; db < 4; ++db) o[db] *= alpha;
        asm volatile("s_waitcnt lgkmcnt(0)" ::: "memory");
#pragma unroll
        for (int u = 0; u < 2; ++u) {
            u32x4 pp;
#pragma unroll
            for (int j = 0; j < 4; ++j) pp[j] = pk_bf16(pe[8 * u + 2 * j], pe[8 * u + 2 * j + 1]);
            const bf16x8 pf = __builtin_bit_cast(bf16x8, pp);
#pragma unroll
            for (int db = 0; db < 4; ++db) {
                const bf16_t* va = vs + (32 * u + 8 * g + (li >> 2)) * SM_VROW + 16 * db + 4 * (li & 3);
                const s16x4 t0 = __builtin_amdgcn_ds_read_tr16_b64_v4i16((LAS s16x4*)(va));
                const s16x4 t1 = __builtin_amdgcn_ds_read_tr16_b64_v4i16((LAS s16x4*)(va + 4 * SM_VROW));
                const bf16x8 vf = {t0[0], t0[1], t0[2], t0[3], t1[0], t1[1], t1[2], t1[3]};
                o[db] = __builtin_amdgcn_mfma_f32_16x16x32_bf16(vf, pf, o[db], 0, 0, 0);
            }
        }
    }
    float lt = l_run; lt += __shfl_xor(lt, 16); lt += __shfl_xor(lt, 32);
    const float inv = 1.0f / lt;
    bf16_t* orow = ob + (size_t)qtok * DM + ooff;
#pragma unroll
    for (int db = 0; db < 4; ++db) {
        u32x2 w; w.x = pk_bf16(o[db][0] * inv, o[db][1] * inv); w.y = pk_bf16(o[db][2] * inv, o[db][3] * inv);
        *(u32x2*)(orow + 16 * db + 4 * g) = w;
    }
}
DI void small_dispatch(const Params& p, int l, int S, int wi, unsigned char* smem) {
    const int wave = __builtin_amdgcn_readfirstlane(otid() >> 6);
    wi = __builtin_amdgcn_readfirstlane(wi);
    bf16_t* vs = (bf16_t*)smem + wave * (64 * SM_VROW);
    const int mode = wi >> 13, rem = wi & 8191, h = rem >> 11, gg = rem & 2047;
    const int gps = S >> 4;
    const int seq = gg / gps, grp = gg - seq * gps;
    SmallItem it; it.mode = mode; it.S = S; it.seqbase = seq * S; it.h = h; it.rowstart = 0; it.cs = 0; it.r = 0; it.rpb = nullptr; it.slope2 = 0.f;
    if (mode == 0) {
        it.q0 = (grp >> 4) * 256 + (grp & 15); it.qstride = 16; it.ntiles = 23;
        it.slope2 = exp2f(-(float)(2 * h + 2)) * LOG2E;
        small_attn_item(p, it, OFF_AQ + 64 * h, OFF_AK + 64 * h, OFF_AV + 64 * h, 0 + 64 * h, 0.f, false, vs);
    } else if (mode == 1) {
        it.q0 = grp * 16; it.qstride = 1; it.ntiles = 9;
        it.slope2 = exp2f(-(float)(2 * h + 1)) * LOG2E;
        const float sink2 = p.sink_logits[l * 4 + h] * LOG2E;
        small_attn_item(p, it, OFF_BQ + 64 * h, OFF_BK + 64 * (h >> 1), OFF_BV + 64 * (h >> 1), 256 + 64 * h, sink2, true, vs);
    } else {
        const int rows = S >> 6; const int r = grp >> 2, c0 = (grp & 3) * 16;
        int rst = r - 4; rst = rst < 0 ? 0 : (rst > rows - 8 ? rows - 8 : rst);
        int cs = c0 - 8; cs = cs < 0 ? 0 : (cs > 32 ? 32 : cs);
        it.q0 = r * 64 + c0; it.qstride = 1; it.ntiles = 8; it.rowstart = rst; it.cs = cs; it.r = r;
        it.rpb = p.na_rpb + (size_t)(l * 4 + h) * 15 * 31;
        small_attn_item(p, it, OFF_DQ + 64 * h, OFF_DK + 64 * h, OFF_DV + 64 * h, 768 + 64 * h, 0.f, false, vs);
    }
}
DI void phase_attention(const Params& p, int l, int S, unsigned char* smem) {
#if (PH_MASK & 16384)
    {
        const int tid_ = otid(); const int wave = tid_ >> 6, lane = tid_ & 63;
        const bf16_t* qc = (const bf16_t*)(p.ws + WS_QC); const bf16_t* kvc = (const bf16_t*)(p.ws + WS_KVC); const bf16_t* kpe = (const bf16_t*)(p.ws + WS_KPE);
        bf16_t* ob = (bf16_t*)(p.ws + WS_H);
        for (int tok = blockIdx.x * 4 + wave; tok < TC; tok += gridDim.x * 4) {
            for (int c = lane; c < 256; c += 64) {
                const int h = c >> 6, d = c & 63;
                const float v = bf2f(qc[(size_t)tok * 384 + h * 96 + d]) + bf2f(qc[(size_t)tok * 384 + h * 96 + 32 + d]) + bf2f(kvc[(size_t)tok * 512 + h * 128 + d]) + bf2f(kvc[(size_t)tok * 512 + h * 128 + 64 + d]) + bf2f(kpe[(size_t)tok * 32 + (d & 31)]);
                ob[(size_t)tok * DM + 512 + c] = (bf16_t)(pk_bf16(v, 0.f) & 0xffffu);
            }
        }
        return;
    }
#endif
    constexpr int NC = 1024, NSMALL = 3 * 4 * 2048 / 4;
    for (int t = blockIdx.x; t < NC + NSMALL; t += gridDim.x) {
        if (t < NC) { if (PH_MASK & 2048) { const int item = (t & 7) * (NC / 8) + (t >> 3); attn_c_item(p, S, item, smem); } }
        else if (PH_MASK & 4096) { __syncthreads(); small_dispatch(p, l, S, (t - NC) * 4 + (otid() >> 6), smem); }
    }
    __syncthreads();
}

constexpr int SMEM_BYTES = 43008;
#ifndef MULTI_LAUNCH
#define MULTI_LAUNCH 0
#endif
DI void run_phase(const Params& p, int chunk, int l, int ph, unsigned char* smem) {
    bf16_t* Hb = (bf16_t*)(p.ws + WS_H); bf16_t* Ub = (bf16_t*)(p.ws + WS_U); bf16_t* proj = (bf16_t*)(p.ws + WS_PROJ);
    bf16_t* qcb = (bf16_t*)(p.ws + WS_QC); bf16_t* kvcb = (bf16_t*)(p.ws + WS_KVC);
    const int S = chunk ? 16384 : 2048;
    float* xo = p.x_out[chunk];
    const float* xsrc = (l == 0) ? p.x_in[chunk] : xo;
    switch (ph) {
    case 0: phase_prologue(p, smem); break;
    case 1: phase_rmsnorm_to_bf16(xsrc, p.norm_attn + l * DM, Hb, TC); break;
    case 2: { GemmArgs g{Hb, DM, (const bf16_t*)(p.ws + WS_WIN) + (size_t)l * PLD * DM, DM, DM}; phase_gemm(g, TC, PLD, EpiBf16{proj, PLD}, smem); } break;
    case 3: phase_mla_prep(p, l, S); break;
    case 4: {
        const GemmArgs gq{(const bf16_t*)(p.ws + WS_CQN), 256, (const bf16_t*)(p.ws + WS_WQUP) + (size_t)l * 384 * 256, 256, 256};
        const GemmArgs gk{(const bf16_t*)(p.ws + WS_CKVN), 128, (const bf16_t*)(p.ws + WS_WKVUP) + (size_t)l * 512 * 128, 128, 128};
        const int n_mt = TC >> 7;
        for (int t = blockIdx.x; t < n_mt * 7; t += gridDim.x) {
            int mt, nt; tile_map(t, n_mt, 7, mt, nt);
            if (nt < 3) gemm_tile(gq, mt << 7, nt << 7, EpiBf16{qcb, 384}, smem);
            else gemm_tile(gk, mt << 7, (nt - 3) << 7, EpiBf16{kvcb, 512}, smem);
        }
    } break;
    case 5: phase_attention(p, l, S, smem); break;
    case 6: phase_group_norm(Hb, p.group_norm + l * DM, TC); break;
    case 7: { GemmArgs g{Hb, DM, (const bf16_t*)(p.ws + WS_WOUT) + (size_t)l * DM * DM, DM, DM}; phase_gemm(g, TC, DM, EpiResid{xsrc, xo}, smem); } break;
    case 8: phase_rmsnorm_to_bf16(xo, p.norm_mlp + l * DM, Hb, TC); break;
    case 9: { GemmArgs g{Hb, DM, (const bf16_t*)(p.ws + WS_WUP) + (size_t)l * DFF * DM, DM, DM}; phase_gemm(g, TC, DFF, EpiRelu2{Ub, DFF}, smem); } break;
    case 10: { GemmArgs g{Ub, DFF, (const bf16_t*)(p.ws + WS_WDOWN) + (size_t)l * DM * DFF, DFF, DFF}; phase_gemm(g, TC, DM, EpiResid{xo, xo}, smem); } break;
    case 12: { GemmArgs g{Hb, DM, (const bf16_t*)(p.ws + WS_WIN) + (size_t)l * PLD * DM, DM, DM}; phase_gemm(g, TC, PLD, EpiBf16{(bf16_t*)(p.ws + WS_U + 100663296), PLD}, smem); } break;
    case 13: { GemmArgs g{Hb, DM, (const bf16_t*)(p.ws + WS_WIN), DM, DM}; phase_gemm(g, TC, PLD, EpiBf16{Ub, DFF}, smem); } break;
    case 14: { GemmArgs g{Hb, DM, (const bf16_t*)(p.ws + WS_WUP), DM, DM}; phase_gemm(g, TC, PLD, EpiBf16{proj, PLD}, smem); } break;
    default: phase_final_norm(p.x_out[chunk], p.norm_final, TC); break;
    }
}
#if MULTI_LAUNCH
__global__ void __launch_bounds__(256, 2) encoder_phase_kernel(Params p, int chunk, int l, int ph) {
    __shared__ __attribute__((aligned(16))) unsigned char smem[SMEM_BYTES];
    run_phase(p, chunk, l, ph, smem);
}
#else
__global__ void __launch_bounds__(256, 3) encoder_megakernel(Params p) {
    __shared__ __attribute__((aligned(16))) unsigned char smem[SMEM_BYTES];
    __shared__ uint4 xb_words;
    if (threadIdx.x == 0) xb_words = make_uint4(0u, 0u, 0u, 0u);
    __syncthreads();
    cg::this_grid().sync();
    XcdBarrier bar = xcd_barrier_post((unsigned*)(p.ws + WS_BAR), (volatile LAS unsigned*)&xb_words);
    run_phase(p, 0, 0, 0, smem);
    xcd_barrier(bar);
#pragma unroll 1
    for (int chunk = 0; chunk < 2; ++chunk) {
#pragma unroll 1
        for (int l = 0; l < DEPTH; ++l) {
#pragma unroll 1
            for (int ph = 1; ph <= 10; ++ph) { run_phase(p, chunk, l, ph, smem); xcd_barrier(bar); }
        }
        run_phase(p, chunk, 0, 11, smem);
    }
}
#endif


#ifndef DIAG
#define DIAG 0
#endif
#if DIAG
__global__ void diag_sum_kernel(const unsigned short* buf, size_t n, unsigned long long* slot  ) {
    unsigned long long s = 0, nf = 0;
    for (size_t i = (size_t)blockIdx.x * blockDim.x + threadIdx.x; i < n; i += (size_t)gridDim.x * blockDim.x) {
        const unsigned v = buf[i]; s += (unsigned long long)v * (unsigned long long)((i & 1023) + 1); nf += ((v & 0x7F80u) == 0x7F80u) ? 1u : 0u;
    }
    atomicAdd(slot, s); atomicAdd(slot + 1, nf);
}
__global__ void diag_mag_kernel(const unsigned short* buf, size_t n, unsigned long long* slot  ) {
    unsigned long long hg = 0, nn = 0, ni = 0;
    for (size_t i = (size_t)blockIdx.x * blockDim.x + threadIdx.x; i < n; i += (size_t)gridDim.x * blockDim.x) {
        const unsigned v = buf[i]; const unsigned e = (v >> 7) & 0xFFu, m = v & 0x7Fu;
        if (e == 0xFFu) { if (m) nn++; else ni++; } else if (e >= 147u) hg++;
    }
    atomicAdd(slot, hg); atomicAdd(slot + 1, nn); atomicAdd(slot + 2, ni);
}
__global__ void diag_zero_kernel(unsigned long long* slots, int n) { for (int i = threadIdx.x; i < n; i += blockDim.x) slots[i] = 0ull; }
__global__ void diag_report_kernel(float* out, size_t n, const unsigned long long* slots) {
    for (size_t i = (size_t)blockIdx.x * blockDim.x + threadIdx.x; i < n; i += (size_t)gridDim.x * blockDim.x) out[i] = 0.f;
    if (blockIdx.x == 0 && threadIdx.x == 0) {
        int bits = 0;
        if (slots[0]) bits |= 1;
        if (slots[4]) bits |= 2;
        if (slots[8]) bits |= 4;
        if (slots[13]) bits |= 8;
        if (slots[14]) bits |= 16;
        if (slots[13] + slots[14] > 1000ull) bits |= 32;
        out[0] = sqrtf((float)(10 + bits) * 33554432.0f * 1.0025f);
    }
}
#endif

extern "C" void kernel_launch(void* const* d_in, const int* in_sizes, int n_in, void* d_out, int out_size, void* d_ws, size_t ws_size, hipStream_t stream) {
    (void)in_sizes; (void)n_in; (void)out_size;
    if (ws_size < WS_END) { fprintf(stderr, "workspace too small: %zu < %zu\n", ws_size, (size_t)WS_END); return; }
    Params p{};
    p.x_in[0] = (const float*)d_in[0]; p.x_in[1] = (const float*)d_in[1];
    p.x_out[0] = (float*)d_out; p.x_out[1] = (float*)d_out + (size_t)TC * DM;
    p.norm_attn = (const float*)d_in[2]; p.w_in = (const float*)d_in[3]; p.mla_q_norm = (const float*)d_in[4]; p.w_q_up = (const float*)d_in[5];
    p.mla_kv_norm = (const float*)d_in[6]; p.w_kv_up = (const float*)d_in[7]; p.sink_logits = (const float*)d_in[8]; p.na_rpb = (const float*)d_in[9];
    p.group_norm = (const float*)d_in[10]; p.w_out = (const float*)d_in[11]; p.norm_mlp = (const float*)d_in[12]; p.w_mlp_up = (const float*)d_in[13];
    p.w_mlp_down = (const float*)d_in[14]; p.norm_final = (const float*)d_in[15];
    p.ws = (unsigned char*)d_ws;
#if MULTI_LAUNCH && DIAG
    {
        const int grid = 512;
        unsigned long long* slots = (unsigned long long*)((unsigned char*)d_ws + 8192);
        diag_zero_kernel<<<1, 64, 0, stream>>>(slots, 64);
        {
            unsigned char* w = (unsigned char*)d_ws;
            encoder_phase_kernel<<<grid, 256, 0, stream>>>(p, 0, 0, 0);
            encoder_phase_kernel<<<grid, 256, 0, stream>>>(p, 0, 0, 1);
            encoder_phase_kernel<<<grid, 256, 0, stream>>>(p, 0, 0, 2);
            diag_mag_kernel<<<1024, 256, 0, stream>>>((const unsigned short*)(w + WS_H), (size_t)TC * DM, slots + 0);
            diag_mag_kernel<<<1024, 256, 0, stream>>>((const unsigned short*)(w + WS_WIN), (size_t)PLD * DM, slots + 4);
            diag_mag_kernel<<<1024, 256, 0, stream>>>((const unsigned short*)(w + WS_WUP), (size_t)DFF * DM, slots + 8);
            diag_mag_kernel<<<1024, 256, 0, stream>>>((const unsigned short*)(w + WS_PROJ), (size_t)TC * PLD, slots + 12);
        }
        diag_report_kernel<<<1024, 256, 0, stream>>>((float*)d_out, (size_t)2 * TC * DM, slots);
        return;
    }
#endif
#if MULTI_LAUNCH
    const int grid = 512;
    encoder_phase_kernel<<<grid, 256, 0, stream>>>(p, 0, 0, 0);
    for (int chunk = 0; chunk < 2; ++chunk) {
        for (int l = 0; l < DEPTH; ++l)
            for (int ph = 1; ph <= 10; ++ph) encoder_phase_kernel<<<grid, 256, 0, stream>>>(p, chunk, l, ph);
        encoder_phase_kernel<<<grid, 256, 0, stream>>>(p, chunk, 0, 11);
    }
#else
    static int grid_blocks = 0;
    if (!grid_blocks) {
        int dev = 0, cus = 0, per_cu = 0;
        (void)hipGetDevice(&dev);
        (void)hipDeviceGetAttribute(&cus, hipDeviceAttributeMultiprocessorCount, dev);
        (void)hipOccupancyMaxActiveBlocksPerMultiprocessor(&per_cu, encoder_megakernel, 256, 0);
        if (per_cu > 3) per_cu = 3;
        if (per_cu < 1) per_cu = 1;
        grid_blocks = cus * per_cu;
    }
    (void)hipMemsetAsync(d_ws, 0, 16384, stream);
    void* args[] = {&p};
    hipError_t e = hipLaunchCooperativeKernel((void*)encoder_megakernel, dim3(grid_blocks), dim3(256), args, 0, stream);
    if (e != hipSuccess) fprintf(stderr, "cooperative launch failed: %s (grid %d)\n", hipGetErrorString(e), grid_blocks);
#endif
}
```
